# Optimizing an MI355X kernel written in HIP

```python
import jax, jax.numpy as jnp
from jax import lax
import numpy as np

D_MODEL = 2048
BATCH = 2
SEQ = 8192
DEPTH = 2

N_EVEN = (DEPTH + 1) // 2
N_ODD = DEPTH // 2
MIX_WIDTH = D_MODEL

A_HEAD_DIM = 128
A_WIDTH = D_MODEL // 2
A_HEADS = A_WIDTH // A_HEAD_DIM
MOBA_BLOCK = 256
MOBA_TOPK = 3
MOBA_Q_CHUNK = 32
B_WIDTH = MIX_WIDTH - A_WIDTH
B_CONV = 3
AB_IN = 3 * A_WIDTH + 3 * B_WIDTH
C_WIDTH = D_MODEL // 2
C_BLOCKS = 8
C_BLOCK_DIM = C_WIDTH // C_BLOCKS
C_CONV = 4
RG_C = 8.0
D_WIDTH = MIX_WIDTH - C_WIDTH
D_HEADS = 4
D_HEAD_DIM = D_WIDTH // D_HEADS
MLSTM_CHUNK = 64
CD_IN = 2 * C_WIDTH + 4 * D_WIDTH + 2 * D_HEADS
FFN_HIDDEN = -(-8 * D_MODEL // (3 * 256)) * 256

EPS = 1e-6
NEG_INF = -1e30

kernel_name = "hybrid_moba_conv_rglru_mlstm_adaln"


def rmsnorm(x, g):
    xf = x.astype(jnp.float32)
    xf = xf * lax.rsqrt(jnp.mean(xf * xf, axis=-1, keepdims=True) + EPS)
    return xf.astype(x.dtype) * g


def alibi_slopes(n_heads):
    return 2.0 ** (-8.0 * jnp.arange(1, n_heads + 1, dtype=jnp.float32) / n_heads)


def causal_depthwise_conv(u, w):
    k_w, ch = w.shape
    return lax.conv_general_dilated(
        u, w[:, None, :].astype(u.dtype), window_strides=(1,), padding=[(k_w - 1, 0)],
        dimension_numbers=('NWC', 'WIO', 'NWC'), feature_group_count=ch)


def moba_attention(q, k, v, slopes):
    bsz, nh, s, dh = q.shape
    nb = -(-s // MOBA_BLOCK)
    pad = nb * MOBA_BLOCK - s
    kb = jnp.pad(k, ((0, 0), (0, 0), (0, pad), (0, 0))).reshape(bsz, nh, nb, MOBA_BLOCK, dh)
    vb = jnp.pad(v, ((0, 0), (0, 0), (0, pad), (0, 0))).reshape(bsz, nh, nb, MOBA_BLOCK, dh)
    scale = dh ** -0.5
    pos = jnp.arange(s, dtype=jnp.int32)
    q_block = pos // MOBA_BLOCK
    k_mean = jnp.mean(kb.astype(jnp.float32), axis=3)
    gate = jnp.einsum('bhsd,bhnd->bhsn', q.astype(jnp.float32), k_mean)
    fully_past = jnp.arange(nb)[None, :] < q_block[:, None]
    gate = jnp.where(fully_past, gate, NEG_INF)
    n_sel = min(MOBA_TOPK, nb)
    _, sel_idx = lax.top_k(gate, n_sel)
    sel_valid = sel_idx < q_block[None, None, :, None]
    b_ix = jnp.arange(bsz)[:, None, None, None]
    h_ix = jnp.arange(nh)[None, :, None, None]
    offs = jnp.arange(MOBA_BLOCK, dtype=jnp.int32)
    ql = MOBA_Q_CHUNK

    def chunk(ci):
        start = ci * ql
        qc = lax.dynamic_slice_in_dim(q, start, ql, axis=2)
        idx = lax.dynamic_slice_in_dim(sel_idx, start, ql, axis=2)
        ok = lax.dynamic_slice_in_dim(sel_valid, start, ql, axis=2)
        t = start + jnp.arange(ql, dtype=jnp.int32)
        k_sel = kb[b_ix, h_ix, idx]
        v_sel = vb[b_ix, h_ix, idx]
        own = start // MOBA_BLOCK
        k_own = lax.dynamic_index_in_dim(kb, own, axis=2, keepdims=False)
        v_own = lax.dynamic_index_in_dim(vb, own, axis=2, keepdims=False)
        s_sel = jnp.einsum('bhqd,bhqnkd->bhqnk', qc, k_sel).astype(jnp.float32) * scale
        dist_sel = (t[:, None, None] - (idx[..., None] * MOBA_BLOCK + offs)).astype(jnp.float32)
        s_sel = jnp.where(ok[..., None], s_sel - slopes[:, None, None, None] * dist_sel, NEG_INF)
        dist_own = (t[:, None] - (own * MOBA_BLOCK + offs)[None, :]).astype(jnp.float32)
        s_own = jnp.einsum('bhqd,bhkd->bhqk', qc, k_own).astype(jnp.float32) * scale
        s_own = jnp.where(dist_own >= 0, s_own - slopes[:, None, None] * dist_own, NEG_INF)
        scores = jnp.concatenate([s_sel.reshape(bsz, nh, ql, n_sel * MOBA_BLOCK), s_own], axis=-1)
        p = jax.nn.softmax(scores, axis=-1).astype(v.dtype)
        p_sel = p[..., :n_sel * MOBA_BLOCK].reshape(bsz, nh, ql, n_sel, MOBA_BLOCK)
        p_own = p[..., n_sel * MOBA_BLOCK:]
        return (jnp.einsum('bhqnk,bhqnkd->bhqd', p_sel, v_sel)
                + jnp.einsum('bhqk,bhkd->bhqd', p_own, v_own))

    out = lax.map(chunk, jnp.arange(s // ql))
    return out.transpose(1, 2, 0, 3, 4).reshape(bsz, nh, s, dh)


def _lin_combine(e1, e2):
    a1, b1 = e1
    a2, b2 = e2
    return a1 * a2, a2 * b1 + b2


def rglru(xc, wa, ba, wx, bx, lam):
    bsz, s, width = xc.shape
    xf = xc.astype(jnp.float32)
    xg = xf.reshape(bsz, s, C_BLOCKS, C_BLOCK_DIM)
    r = jax.nn.sigmoid(jnp.einsum('bsgi,gij->bsgj', xg, wa.astype(jnp.float32)).reshape(bsz, s, width) + ba)
    i = jax.nn.sigmoid(jnp.einsum('bsgi,gij->bsgj', xg, wx.astype(jnp.float32)).reshape(bsz, s, width) + bx)
    log_a = -RG_C * r * jax.nn.softplus(-lam.astype(jnp.float32))
    a = jnp.exp(log_a)
    u = jnp.sqrt(-jnp.expm1(2.0 * log_a)) * (i * xf)
    _, hs = lax.associative_scan(_lin_combine, (a, u), axis=1)
    return hs


def mlstm(q, k, v, i_pre, f_pre):
    bsz, nh, s, d = q.shape
    L = MLSTM_CHUNK
    nc = s // L
    k = k * d ** -0.5
    log_f = jax.nn.log_sigmoid(f_pre)
    to_chunks = lambda t: jnp.moveaxis(t.reshape(bsz, nh, nc, L, *t.shape[3:]), 2, 0)
    causal = jnp.tril(jnp.ones((L, L), dtype=bool))

    def step(carry, inp):
        C, n, m = carry
        qc, kc, vc, ic, lfc = inp
        b = jnp.cumsum(lfc, axis=-1)
        dmat = jnp.where(causal, b[..., :, None] - b[..., None, :] + ic[..., None, :], NEG_INF)
        inter = b + m[..., None]
        m_t = jnp.maximum(inter, jnp.max(dmat, axis=-1))
        w_intra = jnp.exp(dmat - m_t[..., None])
        w_inter = jnp.exp(inter - m_t)
        s_qk = jnp.einsum('bhld,bhsd->bhls', qc, kc) * w_intra
        num = (w_inter[..., None] * jnp.einsum('bhld,bhde->bhle', qc, C)
               + jnp.einsum('bhls,bhse->bhle', s_qk, vc))
        den = w_inter * jnp.einsum('bhld,bhd->bhl', qc, n) + jnp.sum(s_qk, axis=-1)
        h = num / jnp.maximum(jnp.abs(den), jnp.exp(-m_t))[..., None]
        b_last = b[..., -1]
        w_s = b_last[..., None] - b + ic
        m_new = jnp.maximum(b_last + m, jnp.max(w_s, axis=-1))
        decay = jnp.exp(b_last + m - m_new)
        ws = jnp.exp(w_s - m_new[..., None])
        C_new = decay[..., None, None] * C + jnp.einsum('bhs,bhsd,bhse->bhde', ws, kc, vc)
        n_new = decay[..., None] * n + jnp.einsum('bhs,bhsd->bhd', ws, kc)
        return (C_new, n_new, m_new), h

    init = (jnp.zeros((bsz, nh, d, d), jnp.float32), jnp.zeros((bsz, nh, d), jnp.float32),
            jnp.zeros((bsz, nh), jnp.float32))
    _, hs = lax.scan(step, init, (to_chunks(q), to_chunks(k), to_chunks(v),
                                  to_chunks(i_pre), to_chunks(log_f)))
    return jnp.moveaxis(hs, 0, 2).reshape(bsz, nh, s, d)


def mixer_ab(h, w_in, conv_w, w_out, slopes):
    bsz, s, _ = h.shape
    proj = h @ w_in
    q = proj[..., 0:A_WIDTH]
    k = proj[..., A_WIDTH:2 * A_WIDTH]
    v = proj[..., 2 * A_WIDTH:3 * A_WIDTH]
    o = 3 * A_WIDTH
    gate_b = proj[..., o:o + B_WIDTH]
    gate_c = proj[..., o + B_WIDTH:o + 2 * B_WIDTH]
    xb = proj[..., o + 2 * B_WIDTH:o + 3 * B_WIDTH]
    heads = lambda t: t.reshape(bsz, s, A_HEADS, A_HEAD_DIM).transpose(0, 2, 1, 3)
    ya = moba_attention(heads(q), heads(k), heads(v), slopes)
    ya = ya.transpose(0, 2, 1, 3).reshape(bsz, s, A_WIDTH)
    yb = gate_b * causal_depthwise_conv(gate_c * xb, conv_w)
    return jnp.concatenate([ya, yb], axis=-1) @ w_out


def mixer_cd(h, w_in, gate_bias, conv_w, conv_b, wa, ba, wx, bx, lam, w_out):
    bsz, s, _ = h.shape
    proj = h @ w_in
    x_rg = proj[..., 0:C_WIDTH]
    g_rg = proj[..., C_WIDTH:2 * C_WIDTH]
    o = 2 * C_WIDTH
    q = proj[..., o:o + D_WIDTH]
    k = proj[..., o + D_WIDTH:o + 2 * D_WIDTH]
    v = proj[..., o + 2 * D_WIDTH:o + 3 * D_WIDTH]
    og = proj[..., o + 3 * D_WIDTH:o + 4 * D_WIDTH]
    gates = (proj[..., o + 4 * D_WIDTH:] + gate_bias).astype(jnp.float32)
    i_pre = gates[..., :D_HEADS].transpose(0, 2, 1)
    f_pre = gates[..., D_HEADS:].transpose(0, 2, 1)
    xc = causal_depthwise_conv(x_rg, conv_w) + conv_b
    yc = rglru(xc, wa, ba, wx, bx, lam).astype(h.dtype) * jax.nn.gelu(g_rg)
    heads = lambda t: t.reshape(bsz, s, D_HEADS, D_HEAD_DIM).transpose(0, 2, 1, 3).astype(jnp.float32)
    hd = mlstm(heads(q), heads(k), heads(v), i_pre, f_pre)
    yd = hd.transpose(0, 2, 1, 3).reshape(bsz, s, D_WIDTH).astype(h.dtype) * jax.nn.sigmoid(og)
    return jnp.concatenate([yc, yd], axis=-1) @ w_out


def swiglu(h, w1, w3, w2):
    return (jax.nn.silu(h @ w1) * (h @ w3)) @ w2


def setup_inputs(seed: int = 0) -> dict:
    key = jax.random.key(seed)
    ks = jax.random.split(key, 24)
    f32 = jnp.float32
    D = D_MODEL

    def nrm(k, shape, scale):
        return jax.random.normal(k, shape, f32) * scale

    i_b = nrm(ks[13], (N_ODD, D_HEADS), 0.1)
    f_b = jnp.linspace(3.0, 6.0, D_HEADS, dtype=f32)[None, :] + nrm(ks[14], (N_ODD, D_HEADS), 0.1)
    u = jax.random.uniform(ks[21], (N_ODD, C_WIDTH), f32, 0.9, 0.999)
    a0 = u ** (1.0 / RG_C)
    return {
        "x": nrm(ks[0], (BATCH, SEQ, D), 1.0),
        "c": nrm(ks[1], (BATCH, D), 1.0),
        "mod_w": nrm(ks[2], (DEPTH, D, 6 * D), 0.5 * D ** -0.5),
        "mod_b": nrm(ks[3], (DEPTH, 6 * D), 0.02),
        "norm_mix_g": 1.0 + nrm(ks[4], (DEPTH, D), 0.02),
        "norm_ffn_g": 1.0 + nrm(ks[5], (DEPTH, D), 0.02),
        "ffn_w1": nrm(ks[6], (DEPTH, D, FFN_HIDDEN), D ** -0.5),
        "ffn_w3": nrm(ks[7], (DEPTH, D, FFN_HIDDEN), D ** -0.5),
        "ffn_w2": nrm(ks[8], (DEPTH, FFN_HIDDEN, D), FFN_HIDDEN ** -0.5),
        "ab_w_in": nrm(ks[9], (N_EVEN, D, AB_IN), D ** -0.5),
        "ab_conv_w": nrm(ks[10], (N_EVEN, B_CONV, B_WIDTH), B_CONV ** -0.5),
        "ab_w_out": nrm(ks[11], (N_EVEN, MIX_WIDTH, D), MIX_WIDTH ** -0.5),
        "cd_w_in": nrm(ks[12], (N_ODD, D, CD_IN), D ** -0.5),
        "cd_gate_b": jnp.concatenate([i_b, f_b], axis=-1),
        "rg_conv_w": nrm(ks[15], (N_ODD, C_CONV, C_WIDTH), C_CONV ** -0.5),
        "rg_conv_b": nrm(ks[16], (N_ODD, C_WIDTH), 0.02),
        "rg_wa": nrm(ks[17], (N_ODD, C_BLOCKS, C_BLOCK_DIM, C_BLOCK_DIM), C_BLOCK_DIM ** -0.5),
        "rg_ba": nrm(ks[18], (N_ODD, C_WIDTH), 0.02),
        "rg_wx": nrm(ks[19], (N_ODD, C_BLOCKS, C_BLOCK_DIM, C_BLOCK_DIM), C_BLOCK_DIM ** -0.5),
        "rg_bx": nrm(ks[20], (N_ODD, C_WIDTH), 0.02),
        "rg_lambda": jnp.log(a0) - jnp.log1p(-a0),
        "cd_w_out": nrm(ks[22], (N_ODD, MIX_WIDTH, D), MIX_WIDTH ** -0.5),
        "final_norm_g": 1.0 + nrm(ks[23], (D,), 0.02),
    }


def reference(x, c, mod_w, mod_b, norm_mix_g, norm_ffn_g, ffn_w1, ffn_w3, ffn_w2,
              ab_w_in, ab_conv_w, ab_w_out, cd_w_in, cd_gate_b, rg_conv_w, rg_conv_b,
              rg_wa, rg_ba, rg_wx, rg_bx, rg_lambda, cd_w_out, final_norm_g):
    slopes = alibi_slopes(A_HEADS)
    cond = jax.nn.silu(c)
    for layer in range(DEPTH):
        mod = cond @ mod_w[layer] + mod_b[layer]
        sh_m, sc_m, g_m, sh_f, sc_f, g_f = jnp.split(mod[:, None, :], 6, axis=-1)
        h = rmsnorm(x, norm_mix_g[layer]) * (1.0 + sc_m) + sh_m
        if layer % 2 == 0:
            e = layer // 2
            y = mixer_ab(h, ab_w_in[e], ab_conv_w[e], ab_w_out[e], slopes)
        else:
            o = layer // 2
            y = mixer_cd(h, cd_w_in[o], cd_gate_b[o], rg_conv_w[o], rg_conv_b[o], rg_wa[o],
                         rg_ba[o], rg_wx[o], rg_bx[o], rg_lambda[o], cd_w_out[o])
        x = x + g_m * y
        h = rmsnorm(x, norm_ffn_g[layer]) * (1.0 + sc_f) + sh_f
        x = x + g_f * swiglu(h, ffn_w1[layer], ffn_w3[layer], ffn_w2[layer])
    return rmsnorm(x, final_norm_g)
```

```cpp
#include <hip/hip_runtime.h>
#include <cstdio>
#include <cstdint>
namespace pg8 {
#define PG8_LAS __attribute__((address_space(3)))
typedef unsigned short bf16_t;
typedef short bf16x8 __attribute__((ext_vector_type(8)));
typedef float f32x4 __attribute__((ext_vector_type(4)));
typedef unsigned u32x4 __attribute__((ext_vector_type(4)));
constexpr int BM = 256, BK = 64, HALF = 128, HTB = HALF * BK * 2  , STAGE_BYTES = 8 * HTB, NXCD = 8, WGM = 8;

__host__ __device__ __forceinline__ int lds_byte(int r, int c) { const int st = (r >> 4) * 2 + (c >> 5), rr = r & 15, cc = c & 31, ob = rr * 64 + cc * 2; return st * 1024 + (ob ^ (((ob >> 9) & 1) << 5)); }
__host__ __device__ __forceinline__ void stage_rc(int b, int& R, int& C) { const int st = b / 1024, sb = b % 1024, swz = sb ^ (((sb >> 9) & 1) << 5); R = (st >> 1) * 16 + swz / 64; C = (st & 1) * 32 + (swz % 64) / 2; }
__host__ __device__ __forceinline__ int perm32(int rho) { const int n = rho >> 4, i = rho & 15; return 8 * (i >> 2) + 4 * n + (i & 3); }

struct Unit { int pm, pn; };
struct Gemm { const bf16_t* A; const bf16_t* Bt; int M, N, K; };

struct StaticOrder {
    int nM, nN, nwg, G, c;
    __host__ __device__ void init(int M, int N, int G_, int c_) { nM = M / BM; nN = N / BM; nwg = nM * nN; G = G_; c = c_; }
    __host__ __device__ bool next(int i, Unit& u) const {
        const long L = (long)i * G + c; if (L >= nwg) return false;
        int wgid = (int)L; { const int q = nwg / NXCD, r = nwg % NXCD, xcd = wgid % NXCD, off = wgid / NXCD; wgid = (xcd < r ? xcd * (q + 1) : r * (q + 1) + (xcd - r) * q) + off; }
        const int nig = WGM * nN, gid = wgid / nig, fm = gid * WGM, gsz = (nM - fm) < WGM ? (nM - fm) : WGM;
        u.pm = fm + ((wgid % nig) % gsz); u.pn = (wgid % nig) / gsz; return true;
    }
    __device__ __forceinline__ void a_ready(const Unit&) const {}
    __device__ __forceinline__ void done(const Unit&) const {}
};
__device__ __forceinline__ unsigned cvt_pk_bf16(float lo, float hi) { unsigned r; asm volatile("v_cvt_pk_bf16_f32 %0, %1, %2" : "=v"(r) : "v"(lo), "v"(hi)); return r; }
typedef float f32x2 __attribute__((ext_vector_type(2)));
__device__ __forceinline__ f32x4 cvt_i32x4(f32x4 v) { const float f0 = v[0], f1 = v[1], f2 = v[2], f3 = v[3];
    f32x4 r = {(float)__float_as_int(f0), (float)__float_as_int(f1), (float)__float_as_int(f2), (float)__float_as_int(f3)}; return r; }
template <bool IN_I8> struct EpiBf16P {
    static constexpr bool PERM = true, AFTER_DRAIN = false, PRE = false;
    bf16_t* O; int ldc; float* kacc; const float* sa; float inscale; int pn_split = 1 << 30, pn_skip = 0;
    __device__ __forceinline__ void operator()(const f32x4 (&acc)[2][2][4][2], const Unit& u, int wr, int wc, int fr, int fq) const {
        const unsigned loff = (unsigned)((wr * 64 + fr) * ldc + wc * 32 + 8 * fq);
        bf16_t* tile = O + ((size_t)u.pm * BM * ldc + (size_t)(u.pn + (u.pn >= pn_split ? pn_skip : 0)) * BM);
        const bool ksum = kacc != nullptr && (u.pn >> 2) == 1;
        f32x4 ks[2][2];
#pragma unroll
        for (int bj = 0; bj < 2; ++bj)
#pragma unroll
            for (int n = 0; n < 2; ++n) ks[bj][n] = (f32x4){0.f, 0.f, 0.f, 0.f};
#pragma unroll
        for (int ai = 0; ai < 2; ++ai)
#pragma unroll
            for (int m = 0; m < 4; ++m) { bf16_t* rowp = tile + (size_t)(ai * HALF + m * 16) * ldc + loff;
                float rs = 1.0f; if constexpr (IN_I8) rs = sa[u.pm * BM + wr * 64 + fr + ai * HALF + m * 16] * inscale;
#pragma unroll
                for (int bj = 0; bj < 2; ++bj) { f32x4 v0 = acc[ai][bj][m][0], v1 = acc[ai][bj][m][1];
                    if constexpr (IN_I8) { v0 = cvt_i32x4(v0) * rs; v1 = cvt_i32x4(v1) * rs; }
                    ks[bj][0] += v0; ks[bj][1] += v1;
                    u32x4 w; w.x = cvt_pk_bf16(v0[0], v0[1]); w.y = cvt_pk_bf16(v0[2], v0[3]); w.z = cvt_pk_bf16(v1[0], v1[1]); w.w = cvt_pk_bf16(v1[2], v1[3]);
                    *(u32x4*)(rowp + bj * HALF) = w; } }
        if (ksum) {
            float* kp = kacc + (size_t)u.pm * 1024 + (u.pn - 4) * BM + wc * 32 + 8 * fq;
#pragma unroll
            for (int bj = 0; bj < 2; ++bj)
#pragma unroll
                for (int n = 0; n < 2; ++n) { f32x4 s = ks[bj][n];
#pragma unroll
                    for (int o = 1; o < 16; o <<= 1) { s[0] += __shfl_xor(s[0], o); s[1] += __shfl_xor(s[1], o); s[2] += __shfl_xor(s[2], o); s[3] += __shfl_xor(s[3], o); }
                    if (fr == 0) {
#pragma unroll
                        for (int i = 0; i < 4; ++i) __hip_atomic_fetch_add(kp + bj * HALF + 4 * n + i, s[i], __ATOMIC_RELAXED, __HIP_MEMORY_SCOPE_AGENT); } }
        }
    }
};
__device__ __forceinline__ float silu_f(float a) { return a * __builtin_amdgcn_rcpf(1.0f + __builtin_amdgcn_exp2f(-1.4426950409f * a)); }
__device__ __forceinline__ unsigned cvt4_fp8(float a, float b, float c, float d) {
    a = fminf(fmaxf(a, -448.f), 448.f); b = fminf(fmaxf(b, -448.f), 448.f); c = fminf(fmaxf(c, -448.f), 448.f); d = fminf(fmaxf(d, -448.f), 448.f);
    int w = __builtin_amdgcn_cvt_pk_fp8_f32(a, b, 0, false); w = __builtin_amdgcn_cvt_pk_fp8_f32(c, d, w, true); return (unsigned)w; }

template <bool OUT8, bool IN_I8> struct EpiSwiGLU {
    static constexpr bool PERM = true, AFTER_DRAIN = false, PRE = IN_I8;
    void* O; int ldc; float inscale; const float* sa;
    __device__ __forceinline__ void pre(const Unit& u, int wr, int fr, float (&sr)[8]) const {
#pragma unroll
        for (int i = 0; i < 8; ++i) sr[i] = sa[u.pm * BM + wr * 64 + fr + (i >> 2) * HALF + (i & 3) * 16]; }
    __device__ __forceinline__ void operator()(const f32x4 (&acc)[2][2][4][2], const Unit& u, int wr, int wc, int fr, int fq) const { float one[8] = {1.f, 1.f, 1.f, 1.f, 1.f, 1.f, 1.f, 1.f}; (*this)(acc, u, wr, wc, fr, fq, one); }
    __device__ __forceinline__ void operator()(const f32x4 (&acc)[2][2][4][2], const Unit& u, int wr, int wc, int fr, int fq, const float (&srow)[8]) const {
        const unsigned loff = (unsigned)((wr * 64 + fr) * ldc + wc * 32 + 8 * fq); const size_t toff = (size_t)u.pm * BM * ldc + (size_t)u.pn * HALF;
#pragma unroll
        for (int ai = 0; ai < 2; ++ai)
#pragma unroll
            for (int m = 0; m < 4; ++m) { const size_t ro = toff + (size_t)(ai * HALF + m * 16) * ldc;
                float s2 = inscale; if constexpr (IN_I8) s2 *= srow[ai * 4 + m];
                f32x4 a0 = acc[ai][0][m][0], a1 = acc[ai][0][m][1], b0 = acc[ai][1][m][0], b1 = acc[ai][1][m][1];
                if constexpr (IN_I8) { a0 = cvt_i32x4(a0); a1 = cvt_i32x4(a1); b0 = cvt_i32x4(b0); b1 = cvt_i32x4(b1); }
                const float k1 = -1.4426950409f * s2, k2 = s2 * s2;
                const f32x4 t0 = a0 * k1, t1 = a1 * k1; f32x4 d0, d1;
#pragma unroll
                for (int i = 0; i < 4; ++i) { d0[i] = __builtin_amdgcn_exp2f(t0[i]); d1[i] = __builtin_amdgcn_exp2f(t1[i]); }
                d0 = d0 + 1.0f; d1 = d1 + 1.0f;
#pragma unroll
                for (int i = 0; i < 4; ++i) { d0[i] = __builtin_amdgcn_rcpf(d0[i]); d1[i] = __builtin_amdgcn_rcpf(d1[i]); }
                const f32x4 o0 = (a0 * b0) * (d0 * k2), o1 = (a1 * b1) * (d1 * k2);
                const float r0 = o0[0], r1 = o0[1], r2 = o0[2], r3 = o0[3], r4 = o1[0], r5 = o1[1], r6 = o1[2], r7 = o1[3];
                if constexpr (OUT8) { typedef unsigned u32x2 __attribute__((ext_vector_type(2))); u32x2 w; w.x = cvt4_fp8(r0, r1, r2, r3); w.y = cvt4_fp8(r4, r5, r6, r7); *(u32x2*)((unsigned char*)O + ro + loff) = w; }
                else { u32x4 w; w.x = cvt_pk_bf16(r0, r1); w.y = cvt_pk_bf16(r2, r3); w.z = cvt_pk_bf16(r4, r5); w.w = cvt_pk_bf16(r6, r7); *(u32x4*)((bf16_t*)O + ro + loff) = w; } }
    }
};
template <bool BASE_F32> struct EpiResGate {
    static constexpr bool PERM = true, AFTER_DRAIN = false, PRE = false;
    const void* base; bf16_t* out; int ldc; const float* gate; int gstride; float ascale;
    __device__ __forceinline__ void operator()(const f32x4 (&acc)[2][2][4][2], const Unit& u, int wr, int wc, int fr, int fq) const {
        const unsigned loff = (unsigned)((wr * 64 + fr) * ldc + wc * 32 + 8 * fq); const size_t toff = (size_t)u.pm * BM * ldc + (size_t)u.pn * BM;
        const float* gp = gate + (size_t)(u.pm >> 5) * gstride + u.pn * BM + (wc * 32 + 8 * fq);
        f32x4 gv[2][2];
#pragma unroll
        for (int bj = 0; bj < 2; ++bj)
#pragma unroll
            for (int n = 0; n < 2; ++n) gv[bj][n] = *(const f32x4*)(gp + bj * HALF + 4 * n) * ascale;
#pragma unroll
        for (int ai = 0; ai < 2; ++ai) {
            if constexpr (BASE_F32) {
#pragma unroll
                for (int mh = 0; mh < 2; ++mh) { f32x4 bs[2][2][2];
#pragma unroll
                    for (int mm = 0; mm < 2; ++mm)
#pragma unroll
                        for (int bj = 0; bj < 2; ++bj)
#pragma unroll
                            for (int n = 0; n < 2; ++n) bs[mm][bj][n] = __builtin_nontemporal_load((const f32x4*)((const float*)base + toff + (size_t)(ai * HALF + (2 * mh + mm) * 16) * ldc + bj * HALF + 4 * n + loff));
#pragma unroll
                    for (int mm = 0; mm < 2; ++mm) { const int m = 2 * mh + mm; bf16_t* op = out + toff + (size_t)(ai * HALF + m * 16) * ldc;
#pragma unroll
                        for (int bj = 0; bj < 2; ++bj) { const f32x4 x0 = bs[mm][bj][0] + gv[bj][0] * acc[ai][bj][m][0], x1 = bs[mm][bj][1] + gv[bj][1] * acc[ai][bj][m][1];
                            u32x4 w; w.x = cvt_pk_bf16(x0[0], x0[1]); w.y = cvt_pk_bf16(x0[2], x0[3]); w.z = cvt_pk_bf16(x1[0], x1[1]); w.w = cvt_pk_bf16(x1[2], x1[3]); *(u32x4*)(op + bj * HALF + loff) = w; } }
                    asm volatile("" ::: "memory"); }
            } else { u32x4 rb[4][2];
#pragma unroll
                for (int m = 0; m < 4; ++m)
#pragma unroll
                    for (int bj = 0; bj < 2; ++bj) rb[m][bj] = *(const u32x4*)((const bf16_t*)base + toff + (size_t)(ai * HALF + m * 16) * ldc + bj * HALF + loff);
#pragma unroll
                for (int m = 0; m < 4; ++m) { bf16_t* op = out + toff + (size_t)(ai * HALF + m * 16) * ldc;
#pragma unroll
                    for (int bj = 0; bj < 2; ++bj) { const u32x4 r = rb[m][bj];
                        const f32x4 b0 = {__uint_as_float(r.x << 16), __uint_as_float(r.x & 0xffff0000u), __uint_as_float(r.y << 16), __uint_as_float(r.y & 0xffff0000u)}, b1 = {__uint_as_float(r.z << 16), __uint_as_float(r.z & 0xffff0000u), __uint_as_float(r.w << 16), __uint_as_float(r.w & 0xffff0000u)};
                        const f32x4 x0 = b0 + gv[bj][0] * acc[ai][bj][m][0], x1 = b1 + gv[bj][1] * acc[ai][bj][m][1];
                        u32x4 w; w.x = cvt_pk_bf16(x0[0], x0[1]); w.y = cvt_pk_bf16(x0[2], x0[3]); w.z = cvt_pk_bf16(x1[0], x1[1]); w.w = cvt_pk_bf16(x1[2], x1[3]); *(u32x4*)(op + bj * HALF + loff) = w; } }
                asm volatile("" ::: "memory"); }
        }
    }
};
typedef int pg8_v8i __attribute__((ext_vector_type(8))); typedef int pg8_v4i __attribute__((ext_vector_type(4)));
__device__ __forceinline__ pg8_v8i pg8_cat(bf16x8 a, bf16x8 b) { const pg8_v4i x = __builtin_bit_cast(pg8_v4i, a), y = __builtin_bit_cast(pg8_v4i, b); return __builtin_shufflevector(x, y, 0, 1, 2, 3, 4, 5, 6, 7); }
__device__ __forceinline__ void pg8_mfma8(f32x4& acc, pg8_v8i a, pg8_v8i b, int sc) {
    asm volatile("v_mfma_scale_f32_16x16x128_f8f6f4 %0, %1, %2, %0, %3, %3 op_sel_hi:[0,0,0]" : "+v"(acc) : "v"(a), "v"(b), "v"(sc)); }
template <class Epi, class Sched, bool ALIGN_EPI = false, bool SP2 = false, bool FP8 = false, bool I8 = false>
__device__ __forceinline__ void gemm_phase(PG8_LAS unsigned char* lds, const Gemm g, const Sched& S, const Epi& E) {
    int tid = threadIdx.x; asm volatile("" : "+v"(tid));
    const int wid = __builtin_amdgcn_readfirstlane(tid >> 6), lane = tid & 63, wr = wid >> 2, wc = wid & 3, fr = lane & 15, fq = lane >> 4;
    const int K = g.K, nt = K / BK;
    unsigned voffA[2], voffB[2];
#pragma unroll
    for (int i = 0; i < 2; ++i) { int R, C; stage_rc(tid * 16 + i * 8192, R, C); const int Rb = Epi::PERM ? ((R & ~31) + perm32(R & 31)) : R;
        voffA[i] = (unsigned)(R * K + C) * 2u; voffB[i] = (unsigned)(Rb * K + C) * 2u; }
    const size_t kstep = (size_t)(BK * 2);
    const size_t hstep = (size_t)HALF * K * 2;
    const size_t tstep = 2 * hstep;
    const unsigned ldsw = (unsigned)wid * 1024u;
    const int aoff = lds_byte(wr * 64 + fr, fq * 8), boff = lds_byte(wc * 32 + fr, fq * 8);
#define PG8_SA(b, h) (((b) * 2 + (h)) * HTB)
#define PG8_SB(b, h) ((4 + (b) * 2 + (h)) * HTB)
#define PG8_STAGE(bufoff, gbase, voff) do { _Pragma("unroll") for (int _i = 0; _i < 2; ++_i) \
        __builtin_amdgcn_global_load_lds((const unsigned*)((const char*)(gbase) + (voff)[_i]), (PG8_LAS unsigned*)(lds + (bufoff) + ldsw + _i * 8192), 16, 0, 0); } while (0)
#define PG8_LDA(dst, b, h) do { _Pragma("unroll") for (int m = 0; m < 4; ++m) _Pragma("unroll") for (int k = 0; k < 2; ++k) dst[m][k] = *(const PG8_LAS bf16x8*)(lds + PG8_SA(b, h) + aoff + m * 2048 + k * 1024); } while (0)
#define PG8_LDB(dst, b, h) do { _Pragma("unroll") for (int n = 0; n < 2; ++n) _Pragma("unroll") for (int k = 0; k < 2; ++k) dst[n][k] = *(const PG8_LAS bf16x8*)(lds + PG8_SB(b, h) + boff + n * 2048 + k * 1024); } while (0)
#define PG8_MMA(ai, bj, At, Bt) do { __builtin_amdgcn_s_setprio(1); \
        if constexpr (FP8) { _Pragma("unroll") for (int m = 0; m < 4; ++m) _Pragma("unroll") for (int n = 0; n < 2; ++n) \
            pg8_mfma8(acc[ai][bj][m][n], pg8_cat(Bt[n][0], Bt[n][1]), pg8_cat(At[m][0], At[m][1]), unit_scale); } \
        else if constexpr (I8) { _Pragma("unroll") for (int m = 0; m < 4; ++m) _Pragma("unroll") for (int n = 0; n < 2; ++n) _Pragma("unroll") for (int k = 0; k < 2; ++k) \
            acc[ai][bj][m][n] = __builtin_bit_cast(f32x4, __builtin_amdgcn_mfma_i32_16x16x64_i8(__builtin_bit_cast(pg8_v4i, Bt[n][k]), __builtin_bit_cast(pg8_v4i, At[m][k]), __builtin_bit_cast(pg8_v4i, acc[ai][bj][m][n]), 0, 0, 0)); } \
        else { _Pragma("unroll") for (int m = 0; m < 4; ++m) _Pragma("unroll") for (int n = 0; n < 2; ++n) _Pragma("unroll") for (int k = 0; k < 2; ++k) \
            acc[ai][bj][m][n] = __builtin_amdgcn_mfma_f32_16x16x32_bf16(Bt[n][k], At[m][k], acc[ai][bj][m][n], 0, 0, 0); } \
        __builtin_amdgcn_s_setprio(0); } while (0)
#define PG8_WAIT_V(n) asm volatile("s_waitcnt vmcnt(" #n ")" ::: "memory")
#define PG8_WAIT_L(n) asm volatile("s_waitcnt lgkmcnt(" #n ")" ::: "memory")
#define PG8_BAR __builtin_amdgcn_s_barrier()
#define PG8_SCHED __builtin_amdgcn_sched_barrier(0)
    Unit cur, nxt; int ui = 0;
    if (!S.next(0, cur)) return;
    f32x4 acc[2][2][4][2];
#pragma unroll
    for (int a = 0; a < 2; ++a)
#pragma unroll
        for (int b = 0; b < 2; ++b)
#pragma unroll
            for (int m = 0; m < 4; ++m)
#pragma unroll
                for (int n = 0; n < 2; ++n) acc[a][b][m][n] = (f32x4){0.f, 0.f, 0.f, 0.f};
    bf16x8 At[4][2], B0[2][2], B1[2][2]; int unit_scale = 0x7F7F7F7F; asm volatile("" : "+v"(unit_scale));
    const char* cA = (const char*)g.A + (size_t)cur.pm * tstep; const char* cB = (const char*)g.Bt + (size_t)cur.pn * tstep;
    float epre[8];
    if constexpr (Epi::PRE) E.pre(cur, wr, fr, epre);
    S.a_ready(cur);
    if constexpr (SP2) {
        PG8_STAGE(PG8_SB(0, 0), cB, voffB); PG8_STAGE(PG8_SB(0, 1), cB + hstep, voffB); PG8_STAGE(PG8_SA(0, 0), cA, voffA); PG8_STAGE(PG8_SA(0, 1), cA + hstep, voffA);
        if (wr == 1) PG8_BAR;
        PG8_WAIT_V(2); PG8_BAR;
        PG8_STAGE(PG8_SB(1, 0), cB + kstep, voffB); PG8_STAGE(PG8_SA(1, 0), cA + kstep, voffA); PG8_STAGE(PG8_SB(1, 1), cB + hstep + kstep, voffB);
        PG8_WAIT_V(6); PG8_BAR;
    } else {
        PG8_STAGE(PG8_SB(0, 0), cB, voffB); PG8_STAGE(PG8_SA(0, 0), cA, voffA); PG8_STAGE(PG8_SB(0, 1), cB + hstep, voffB); PG8_STAGE(PG8_SA(0, 1), cA + hstep, voffA);
        if (wr == 1) PG8_BAR;
        PG8_WAIT_V(4); PG8_BAR;
        PG8_STAGE(PG8_SB(1, 0), cB + kstep, voffB); PG8_STAGE(PG8_SA(1, 0), cA + kstep, voffA); PG8_STAGE(PG8_SB(1, 1), cB + hstep + kstep, voffB);
        PG8_WAIT_V(6); PG8_BAR;
    }
    for (;;) {
        const bool has_next = S.next(ui + 1, nxt);
        const char* nA = has_next ? (const char*)g.A + (size_t)nxt.pm * tstep : cA; const char* nB = has_next ? (const char*)g.Bt + (size_t)nxt.pn * tstep : cB;
        for (int t = 0; t < nt; t += 2) {
            const bool last = (t == nt - 2);
            const char* a1 = cA + (size_t)(t + 1) * kstep;
            const char* a2 = last ? nA : cA + (size_t)(t + 2) * kstep; const char* b2 = last ? nB : cB + (size_t)(t + 2) * kstep;
            const char* a3 = a2 + kstep; const char* b3 = b2 + kstep;
            if (last && has_next) S.a_ready(nxt);
            if constexpr (SP2) {
            PG8_LDB(B0, 0, 0); PG8_LDB(B1, 0, 1); PG8_SCHED; PG8_LDA(At, 0, 0); PG8_STAGE(PG8_SA(1, 1), a1 + hstep, voffA);
            PG8_WAIT_V(8); PG8_WAIT_L(0); PG8_BAR; PG8_MMA(0, 0, At, B0); PG8_MMA(0, 1, At, B1); PG8_BAR; PG8_SCHED;
            PG8_LDA(At, 0, 1); PG8_STAGE(PG8_SB(0, 0), b2, voffB); PG8_STAGE(PG8_SB(0, 1), b2 + hstep, voffB); PG8_STAGE(PG8_SA(0, 0), a2, voffA);
            PG8_WAIT_V(8); PG8_WAIT_L(0); PG8_BAR; PG8_MMA(1, 0, At, B0); PG8_MMA(1, 1, At, B1); PG8_BAR; PG8_SCHED;
            PG8_LDB(B0, 1, 0); PG8_LDB(B1, 1, 1); PG8_SCHED; PG8_LDA(At, 1, 0); PG8_STAGE(PG8_SA(0, 1), a2 + hstep, voffA);
            PG8_WAIT_V(8); PG8_WAIT_L(0); PG8_BAR; PG8_MMA(0, 0, At, B0); PG8_MMA(0, 1, At, B1); PG8_BAR; PG8_SCHED;
            PG8_LDA(At, 1, 1); PG8_STAGE(PG8_SB(1, 0), b3, voffB); PG8_STAGE(PG8_SB(1, 1), b3 + hstep, voffB); PG8_STAGE(PG8_SA(1, 0), a3, voffA);
            PG8_WAIT_V(8); PG8_WAIT_L(0); PG8_BAR; PG8_MMA(1, 0, At, B0); PG8_MMA(1, 1, At, B1); PG8_BAR; PG8_SCHED;
            } else {
            PG8_LDB(B0, 0, 0); PG8_SCHED; PG8_LDA(At, 0, 0); PG8_STAGE(PG8_SA(1, 1), a1 + hstep, voffA);
            PG8_WAIT_L(8); PG8_BAR; PG8_WAIT_L(0); PG8_MMA(0, 0, At, B0); PG8_BAR; PG8_SCHED;
            PG8_LDB(B1, 0, 1); PG8_STAGE(PG8_SB(0, 0), b2, voffB);
            PG8_BAR; PG8_WAIT_L(0); PG8_MMA(0, 1, At, B1); PG8_BAR;
            PG8_LDA(At, 0, 1); PG8_STAGE(PG8_SA(0, 0), a2, voffA);
            PG8_BAR; PG8_WAIT_L(0); PG8_MMA(1, 0, At, B0); PG8_BAR; PG8_SCHED;
            PG8_STAGE(PG8_SB(0, 1), b2 + hstep, voffB);
            PG8_WAIT_V(6); PG8_BAR; PG8_MMA(1, 1, At, B1); PG8_BAR;
            PG8_LDB(B0, 1, 0); PG8_SCHED; PG8_LDA(At, 1, 0); PG8_STAGE(PG8_SA(0, 1), a2 + hstep, voffA);
            PG8_WAIT_L(8); PG8_BAR; PG8_WAIT_L(0); PG8_MMA(0, 0, At, B0); PG8_BAR; PG8_SCHED;
            PG8_LDB(B1, 1, 1); PG8_STAGE(PG8_SB(1, 0), b3, voffB);
            PG8_BAR; PG8_WAIT_L(0); PG8_MMA(0, 1, At, B1); PG8_BAR;
            PG8_LDA(At, 1, 1); PG8_STAGE(PG8_SA(1, 0), a3, voffA);
            PG8_BAR; PG8_WAIT_L(0); PG8_MMA(1, 0, At, B0); PG8_BAR; PG8_SCHED;
            PG8_STAGE(PG8_SB(1, 1), b3 + hstep, voffB);
            PG8_WAIT_V(6); PG8_BAR; PG8_MMA(1, 1, At, B1); PG8_BAR;
            }
        }
        if constexpr (ALIGN_EPI) { if (wr == 0) PG8_BAR; }
        if constexpr (FP8) asm volatile("s_nop 15\n\ts_nop 15\n\ts_nop 15" ::: "memory");
        if constexpr (!Epi::AFTER_DRAIN) { if constexpr (Epi::PRE) E(acc, cur, wr, wc, fr, fq, epre); else E(acc, cur, wr, wc, fr, fq); S.done(cur); }
        if (!has_next) break;
#pragma unroll
        for (int a = 0; a < 2; ++a)
#pragma unroll
            for (int b = 0; b < 2; ++b)
#pragma unroll
                for (int m = 0; m < 4; ++m)
#pragma unroll
                    for (int n = 0; n < 2; ++n) acc[a][b][m][n] = (f32x4){0.f, 0.f, 0.f, 0.f};
        cur = nxt; cA = nA; cB = nB; ++ui;
        if constexpr (Epi::PRE) E.pre(cur, wr, fr, epre);
        if constexpr (ALIGN_EPI) { if (wr == 1) PG8_BAR; }
    }
    PG8_WAIT_V(0);
    if constexpr (!ALIGN_EPI) { if (wr == 0) PG8_BAR; }
    PG8_BAR;
    if constexpr (Epi::AFTER_DRAIN) { E.fused(acc, cur, wr, wc, fr, fq, lds, wid, lane); S.done(cur); }
#undef PG8_SA
#undef PG8_SB
#undef PG8_STAGE
#undef PG8_LDA
#undef PG8_LDB
#undef PG8_MMA
#undef PG8_WAIT_V
#undef PG8_WAIT_L
#undef PG8_BAR
#undef PG8_SCHED
}
}
#define GAS __attribute__((address_space(1)))
#define LAS __attribute__((address_space(3)))
#define XB_TMO      128
#define XB_XCNT(j)  (256  + 64 * (j))
#define XB_XSUB(j)  (1280 + 64 * (j))
#define XB_XGEN(j)  (2304 + 64 * (j))
#define XB_TOP      3328
#define XB_TOPGEN   3392
#define XCD_BAR_WORDS 3456
#define XB_SPIN_CAP (1u << 18)

__device__ __forceinline__ unsigned xb_ld(unsigned* p)              { return __hip_atomic_load(p, __ATOMIC_RELAXED, __HIP_MEMORY_SCOPE_AGENT); }
__device__ __forceinline__ unsigned xb_add(unsigned* p, unsigned v) { return __hip_atomic_fetch_add(p, v, __ATOMIC_RELAXED, __HIP_MEMORY_SCOPE_AGENT); }
__device__ __forceinline__ unsigned xb_xcc_id() { return (unsigned)__builtin_amdgcn_s_getreg((3 << 11) | 20) & 0xFu; }
#define XB_SPIN(cond, bar) do { unsigned _sp = 0; while (cond) { __builtin_amdgcn_s_sleep(1); \
    if ((++_sp & 255u) == 0u) { if (xb_ld(&(bar)[XB_TMO])) break; if (_sp > XB_SPIN_CAP) { atomicAdd(&(bar)[XB_TMO], 1u); break; } } } } while (0)

struct XcdBarrier {
    unsigned* bar; unsigned x;
    volatile LAS unsigned* st;
};

__device__ __forceinline__ XcdBarrier xcd_barrier_post(unsigned* bar, volatile LAS unsigned* st) {
    XcdBarrier b; b.bar = bar; b.x = xb_xcc_id(); b.st = st;
    if (threadIdx.x == 0) (void)xb_add(&bar[XB_XCNT(b.x)], 1u);
    return b;
}
__device__ __forceinline__ void xcd_barrier_complete(unsigned* bar, unsigned x, unsigned& nloc, unsigned& nx) {
    const unsigned G = gridDim.x * gridDim.y * gridDim.z;
    unsigned sum, cnt, mine, sp = 0u;
    for (;;) {
        sum = 0u; cnt = 0u; mine = 0u;
#pragma unroll
        for (unsigned j = 0; j < 16; ++j) { const unsigned c = xb_ld(&bar[XB_XCNT(j)]); sum += c; cnt += (c > 0u) ? 1u : 0u; mine = (j == x) ? c : mine; }
        if (sum == G) break;
        __builtin_amdgcn_s_sleep(1);
        if ((++sp & 255u) == 0u) { if (xb_ld(&bar[XB_TMO])) break; if (sp > XB_SPIN_CAP) { atomicAdd(&bar[XB_TMO], 1u); break; } }
    }
    nloc = mine > 0u ? mine : 1u; nx = cnt > 0u ? cnt : 1u;
}

__device__ __forceinline__ void xcd_barrier(const XcdBarrier& b) {
    asm volatile("s_waitcnt vmcnt(0)" ::: "memory");
    __syncthreads();
    if (threadIdx.x == 0) {
        unsigned* bar = b.bar;
        __builtin_amdgcn_s_waitcnt(0);
        unsigned nloc = b.st[0], nx = b.st[1];
        if (nloc == 0u) { xcd_barrier_complete(bar, b.x, nloc, nx); b.st[0] = nloc; b.st[1] = nx; }
        const unsigned old = xb_add(&bar[XB_XSUB(b.x)], 1u);
        const unsigned gen = old / nloc;
        if (old + 1u == (gen + 1u) * nloc) {
            __builtin_amdgcn_fence(__ATOMIC_RELEASE, "agent");
            asm volatile("s_waitcnt vmcnt(0)" ::: "memory");
            const unsigned og = xb_add(&bar[XB_TOP], 1u);
            const unsigned tg = og / nx;
            if (og + 1u == (tg + 1u) * nx) xb_add(&bar[XB_TOPGEN], 1u);
            else XB_SPIN(xb_ld(&bar[XB_TOPGEN]) == tg, bar);
            __builtin_amdgcn_fence(__ATOMIC_ACQUIRE, "agent");
            xb_add(&bar[XB_XGEN(b.x)], 1u);
            asm volatile("s_waitcnt vmcnt(0)" ::: "memory");
        } else {
            XB_SPIN(xb_ld(&bar[XB_XGEN(b.x)]) == gen, bar);
            __builtin_amdgcn_fence(__ATOMIC_ACQUIRE, "agent");
            asm volatile("s_waitcnt vmcnt(0)" ::: "memory");
        }
    }
    __syncthreads();
}
constexpr int BATCH = 2, SEQ = 8192, D = 2048, M = BATCH * SEQ, FF = 5632, NIN = 6144, N13 = 2 * FF, CDPITCH = 6152, MODW = 6 * D;
constexpr float EPS = 1e-6f;
#ifndef FFN0_DOWN_FP8
#define FFN0_DOWN_FP8 1
#endif
#ifndef INPROJ0_I8
#define INPROJ0_I8 2
#endif
#ifndef INPROJ1_I8
#define INPROJ1_I8 1
#endif
#ifndef UP1_FP8
#define UP1_FP8 1
#endif
#ifndef OUT1_FP8
#define OUT1_FP8 1
#endif
constexpr float WIN_QW = 1024.f, W13_QW = 1024.f, W2_SCALE = 64.f, WOUT_SCALE = 32.f;
constexpr int NWAVES = 8, NT = NWAVES * 64;
constexpr size_t MiB = 1u << 20;
constexpr size_t WS_CTL = 0, CTL_ZERO_BYTES = 1 * MiB;
constexpr int CW_BAR = 4096; constexpr size_t CTL_KACC = 256 * 1024, CTL_MCNT = 512 * 1024, CTL_MQ = 520 * 1024;
constexpr size_t LW_IN = 0, LW_OUT = 24 * MiB, LW_13 = 32 * MiB, LW_2 = 76 * MiB, LW_SIZE = 98 * MiB;
constexpr size_t WS_W = 1 * MiB;
constexpr size_t WS_SMALL = 197 * MiB;
constexpr size_t SM_SA = 3 * MiB;
constexpr size_t SM_MOD = 0, SM_WAT = 256 * 1024, SM_WXT = 512 * 1024, SM_GATES = 768 * 1024, SM_SUMM = 1280 * 1024, SM_CH = 1792 * 1024, SM_CHS = 1856 * 1024, SM_NST = 2 * MiB;
constexpr size_t WS_XN = 208 * MiB;
constexpr size_t WS_PROJ = 272 * MiB;
constexpr size_t WS_YCAT = 464 * MiB;
constexpr size_t WS_S1 = 528 * MiB;
constexpr size_t WS_S2 = 592 * MiB;
constexpr size_t WS_XB = 656 * MiB;
constexpr size_t WS_END = 720 * MiB;
constexpr int LDS_BYTES = 163840, MISC_OFF = LDS_BYTES - 512;

typedef unsigned short bf16;
typedef unsigned v4u __attribute__((ext_vector_type(4)));
typedef unsigned v2u __attribute__((ext_vector_type(2)));
typedef float f32x4 __attribute__((ext_vector_type(4)));
typedef float f32x16 __attribute__((ext_vector_type(16)));
typedef short bf16x8 __attribute__((ext_vector_type(8)));
typedef short s16x4 __attribute__((ext_vector_type(4)));
typedef short v4i16_t __attribute__((ext_vector_type(4)));
typedef float f32x2_t __attribute__((ext_vector_type(2)));
typedef __bf16 bf16x2_t __attribute__((ext_vector_type(2)));
#define DI __device__ __forceinline__
DI float bf2f(unsigned v) { return __uint_as_float(v << 16); }
DI float bflo(unsigned v) { return __uint_as_float(v << 16); }
DI float bfhi(unsigned v) { return __uint_as_float(v & 0xffff0000u); }
DI unsigned pk2(float lo, float hi) { f32x2_t v = {lo, hi}; bf16x2_t b = __builtin_convertvector(v, bf16x2_t); return __builtin_bit_cast(unsigned, b); }
DI unsigned pack4_i8(float a, float b, float c, float d) { const int ia = (int)rintf(fminf(fmaxf(a, -127.f), 127.f)), ib = (int)rintf(fminf(fmaxf(b, -127.f), 127.f)), ic = (int)rintf(fminf(fmaxf(c, -127.f), 127.f)), id = (int)rintf(fminf(fmaxf(d, -127.f), 127.f));
    return (unsigned)(ia & 0xff) | ((unsigned)(ib & 0xff) << 8) | ((unsigned)(ic & 0xff) << 16) | ((unsigned)id << 24); }
DI float wave_sum(float v) {
#pragma unroll
    for (int o = 1; o < 64; o <<= 1) v += __shfl_xor(v, o);
    return v; }
DI float wave_max(float v) {
#pragma unroll
    for (int o = 1; o < 64; o <<= 1) v = fmaxf(v, __shfl_xor(v, o));
    return v; }
DI int crow(int r, int hi) { return (r & 3) + 8 * (r >> 2) + 4 * hi; }
DI f32x16 mfma32(bf16x8 a, bf16x8 b, f32x16 c) { return __builtin_amdgcn_mfma_f32_32x32x16_bf16(a, b, c, 0, 0, 0); }
DI s16x4 tr_read(LAS unsigned char* p) { return __builtin_bit_cast(s16x4, __builtin_amdgcn_ds_read_tr16_b64_v4i16((LAS v4i16_t*)p)); }
DI bf16x8 tr_frag(LAS unsigned char* base, int pitch, int r0, int r1, int cbyte, int q) {
    const s16x4 lo = tr_read(base + (r0 + q) * pitch + cbyte), hi = tr_read(base + (r1 + q) * pitch + cbyte);
    return __builtin_shufflevector(lo, hi, 0, 1, 2, 3, 4, 5, 6, 7); }
DI float fexp(float x) { return __builtin_amdgcn_exp2f(1.4426950408889634f * x); }
DI float sigmoid_f(float x) { return __builtin_amdgcn_rcpf(1.0f + fexp(-x)); }
DI float gelu_tanh(float x) { const float u = 0.7978845608f * (x + 0.044715f * x * x * x); const float th = 1.0f - 2.0f * __builtin_amdgcn_rcpf(fexp(2.0f * u) + 1.0f); return 0.5f * x * (1.0f + th); }
DI float log_sigmoid_f(float f) { return f >= 0.f ? -log1pf(fexp(-f)) : f - log1pf(fexp(f)); }
DI void wg_sync() { asm volatile("s_waitcnt lgkmcnt(0)" ::: "memory"); __builtin_amdgcn_s_barrier(); asm volatile("" ::: "memory"); }
#define ZERO16(v) do { _Pragma("unroll") for (int _z = 0; _z < 16; ++_z) (v)[_z] = 0.f; } while (0)

struct Args { const float* in[23]; float* out; unsigned char* ws; };
struct Ctx { LAS unsigned char* lds; int tid, lane, wave, G, bid, gw, ngw; };
DI Ctx fresh(const Ctx& C0) { Ctx C = C0; int t = C0.tid; asm volatile("" : "+v"(t)); C.tid = t; C.lane = t & 63; C.wave = __builtin_amdgcn_readfirstlane(t >> 6); C.gw = C.bid * NWAVES + C.wave; return C; }

DI void p0_transpose_item(const float* W, int pitch, int K, bf16* WT, int k0, int n0, int drow0, LAS float* scr, int lane) {
    float rr[32]; const float* wp = W + (size_t)(k0 + (lane >> 5)) * pitch + n0 + (lane & 31);
#pragma unroll
    for (int i = 0; i < 32; ++i) rr[i] = __builtin_nontemporal_load(wp + (size_t)(2 * i) * pitch);
#pragma unroll
    for (int i = 0; i < 32; ++i) scr[(2 * i + (lane >> 5)) * 33 + (lane & 31)] = rr[i];
    asm volatile("s_waitcnt lgkmcnt(0)" ::: "memory");
    const int c = lane & 7;
#pragma unroll
    for (int j = 0; j < 4; ++j) { const int n = (lane >> 3) + 8 * j; const LAS float* s = scr + (8 * c) * 33 + n;
        v4u o; o.x = pk2(s[0 * 33], s[1 * 33]); o.y = pk2(s[2 * 33], s[3 * 33]); o.z = pk2(s[4 * 33], s[5 * 33]); o.w = pk2(s[6 * 33], s[7 * 33]);
        *(v4u*)(WT + (size_t)(drow0 + n) * K + k0 + 8 * c) = o; }
    asm volatile("s_waitcnt lgkmcnt(0)" ::: "memory");
}
template <bool I8>
DI void p0_transpose_item8(const float* W, int pitch, int K, unsigned char* WT, int k0, int n0, int drow0, float sc, LAS float* scr, int lane) {
    float rr[32]; const float* wp = W + (size_t)(k0 + (lane >> 5)) * pitch + n0 + (lane & 31);
#pragma unroll
    for (int i = 0; i < 32; ++i) rr[i] = __builtin_nontemporal_load(wp + (size_t)(2 * i) * pitch);
#pragma unroll
    for (int i = 0; i < 32; ++i) scr[(2 * i + (lane >> 5)) * 33 + (lane & 31)] = rr[i];
    asm volatile("s_waitcnt lgkmcnt(0)" ::: "memory");
    const int c = lane & 7;
#pragma unroll
    for (int j = 0; j < 4; ++j) { const int n = (lane >> 3) + 8 * j; const LAS float* s = scr + (8 * c) * 33 + n;
        v2u o; if (I8) { o.x = pack4_i8(s[0 * 33] * sc, s[1 * 33] * sc, s[2 * 33] * sc, s[3 * 33] * sc); o.y = pack4_i8(s[4 * 33] * sc, s[5 * 33] * sc, s[6 * 33] * sc, s[7 * 33] * sc); }
        else { o.x = pg8::cvt4_fp8(s[0 * 33] * sc, s[1 * 33] * sc, s[2 * 33] * sc, s[3 * 33] * sc); o.y = pg8::cvt4_fp8(s[4 * 33] * sc, s[5 * 33] * sc, s[6 * 33] * sc, s[7 * 33] * sc); }
        *(v2u*)(WT + (size_t)(drow0 + n) * K + k0 + 8 * c) = o; }
    asm volatile("s_waitcnt lgkmcnt(0)" ::: "memory");
}
DI void p0_prologue(const Args& a, const Ctx& C) {
    LAS float* cond = (LAS float*)(C.lds + 131072);
#pragma unroll
    for (int ii = 0; ii < 2 * D / NT; ++ii) { const int i = C.tid + NT * ii; const float v = a.in[1][i]; cond[i] = v / (1.0f + fexp(-v)); }
    wg_sync();
    float* MOD = (float*)(a.ws + WS_SMALL + SM_MOD);
    if (C.gw < 768) {
        const int layer = C.gw / 384, col0 = (C.gw % 384) * 32, rs = C.lane >> 3, cq = C.lane & 7;
        const float* Wm = a.in[2] + (size_t)layer * D * MODW + col0 + 4 * cq;
        f32x4 a0 = {0.f, 0.f, 0.f, 0.f}, a1 = {0.f, 0.f, 0.f, 0.f};
#pragma unroll 16
        for (int k = 0; k < D; k += 8) { const int row = k + rs; const f32x4 w = __builtin_nontemporal_load((const f32x4*)(Wm + (size_t)row * MODW)); a0 += cond[row] * w; a1 += cond[D + row] * w; }
#pragma unroll
        for (int o = 8; o < 64; o <<= 1) {
#pragma unroll
            for (int i = 0; i < 4; ++i) { a0[i] += __shfl_xor(a0[i], o); a1[i] += __shfl_xor(a1[i], o); } }
        if (C.lane < 8) { const f32x4 bb = *(const f32x4*)(a.in[3] + (size_t)layer * MODW + col0 + 4 * cq);
            *(f32x4*)(MOD + ((size_t)layer * 2 + 0) * MODW + col0 + 4 * cq) = a0 + bb; *(f32x4*)(MOD + ((size_t)layer * 2 + 1) * MODW + col0 + 4 * cq) = a1 + bb; }
    }
    LAS float* scr = (LAS float*)(C.lds + C.wave * 16384);
    constexpr int I_IN = 32 * 192, I_OUT = 32 * 64, I_1 = 32 * 176, I_2 = 88 * 64, I_L = I_IN + I_OUT + 2 * I_1 + I_2, I_ALL = 2 * I_L + 128;
    for (int it = C.gw; it < I_ALL; it += C.ngw) {
        if (it >= 2 * I_L) {
            const int r = it - 2 * I_L, mat = r >> 6, g = (r >> 3) & 7, sub = r & 7, kb = sub >> 2, nb = sub & 3;
            const float* W = (mat ? a.in[18] : a.in[16]) + g * 16384; bf16* WT = (bf16*)(a.ws + WS_SMALL + (mat ? SM_WXT : SM_WAT)) + g * 16384;
            p0_transpose_item(W, 128, 128, WT, 64 * kb, 32 * nb, 32 * nb, scr, C.lane); continue; }
        const int layer = it / I_L; int r = it % I_L; unsigned char* wl = a.ws + WS_W + (size_t)layer * LW_SIZE;
        if (r < I_IN) { const int kb = r / 192, nb = r % 192; if (!layer && INPROJ0_I8 && (INPROJ0_I8 == 1 || nb < 96)) p0_transpose_item8<true>(a.in[9], NIN, D, wl + LW_IN, 64 * kb, 32 * nb, 32 * nb, WIN_QW, scr, C.lane);
            else if (layer && INPROJ1_I8 && (nb < 64 || nb >= 128)) p0_transpose_item8<true>(a.in[12], CDPITCH, D, wl + LW_IN, 64 * kb, 32 * nb, nb < 64 ? 32 * nb : 32 * nb - 2048, WIN_QW, scr, C.lane);
            else p0_transpose_item(layer ? a.in[12] : a.in[9], layer ? CDPITCH : NIN, D, (bf16*)(wl + LW_IN), 64 * kb, 32 * nb, 32 * nb, scr, C.lane); continue; } r -= I_IN;
        if (r < I_OUT) { const int kb = r / 64, nb = r % 64; if (layer && OUT1_FP8) p0_transpose_item8<false>(a.in[21], D, D, wl + LW_OUT, 64 * kb, 32 * nb, 32 * nb, WOUT_SCALE, scr, C.lane);
            else p0_transpose_item(layer ? a.in[21] : a.in[11], D, D, (bf16*)(wl + LW_OUT), 64 * kb, 32 * nb, 32 * nb, scr, C.lane); continue; } r -= I_OUT;
        if (r < 2 * I_1) { const int w3 = r >= I_1; if (w3) r -= I_1; const int kb = r / 176, nb = r % 176, n0 = 32 * nb;
            const float* W = (w3 ? a.in[7] : a.in[6]) + (size_t)layer * D * FF; const int dr = (n0 >> 7) * 256 + (n0 & 127) + (w3 ? 128 : 0);
            if (layer && UP1_FP8) p0_transpose_item8<false>(W, FF, D, wl + LW_13, 64 * kb, n0, dr, 64.0f, scr, C.lane); else p0_transpose_item8<true>(W, FF, D, wl + LW_13, 64 * kb, n0, dr, W13_QW, scr, C.lane); continue; } r -= 2 * I_1;
        { const int kb = r / 64, nb = r % 64; const float* W = a.in[8] + (size_t)layer * FF * D;
          if (layer || FFN0_DOWN_FP8) p0_transpose_item8<false>(W, D, FF, wl + LW_2, 64 * kb, 32 * nb, 32 * nb, W2_SCALE, scr, C.lane); else p0_transpose_item(W, D, FF, (bf16*)(wl + LW_2), 64 * kb, 32 * nb, 32 * nb, scr, C.lane); }
    }
}

template <bool GATES, int OUTM, bool SRCB>
DI void norm_phase(const void* src, const float* gain, const float* sh, const float* sc, bf16* dst, const float* wg, const float* gate_b, float* gates, float* sa, const Ctx& C, unsigned char* dst8 = nullptr) {
    LAS float* WG = (LAS float*)C.lds;
    if (GATES) {
#pragma unroll 8
        for (int i = 0; i < 8 * D / NT; ++i) { const int idx = C.tid + NT * i, k = idx >> 3, j = idx & 7; WG[j * D + (k & ~511) + 256 * ((k >> 2) & 1) + 4 * ((k & 511) >> 3) + (k & 3)] = wg[(size_t)k * CDPITCH + NIN + j]; }
        wg_sync(); }
    int curb = -1; f32x4 A[8], B[8];
    for (int m = C.gw; m < M; m += C.ngw) {
        const int b = m >> 13;
        if (b != curb) { curb = b;
#pragma unroll
            for (int j = 0; j < 8; ++j) { const int col = 8 * C.lane + 512 * (j >> 1) + 4 * (j & 1); const f32x4 g = *(const f32x4*)(gain + col), s1 = *(const f32x4*)(sc + (size_t)b * MODW + col); A[j] = g * (1.0f + s1); B[j] = *(const f32x4*)(sh + (size_t)b * MODW + col); } }
        f32x4 v[8]; float ss = 0.f;
        if (SRCB) { const v4u* xr = (const v4u*)((const bf16*)src + (size_t)m * D) + C.lane;
#pragma unroll
            for (int g = 0; g < 4; ++g) { const v4u r = xr[64 * g]; v[2 * g] = (f32x4){bflo(r.x), bfhi(r.x), bflo(r.y), bfhi(r.y)}; v[2 * g + 1] = (f32x4){bflo(r.z), bfhi(r.z), bflo(r.w), bfhi(r.w)}; } }
        else { const f32x4* xr = (const f32x4*)((const float*)src + (size_t)m * D) + 2 * C.lane;
#pragma unroll
            for (int j = 0; j < 8; ++j) v[j] = xr[128 * (j >> 1) + (j & 1)]; }
#pragma unroll
        for (int j = 0; j < 8; ++j) ss += (v[j].x * v[j].x + v[j].y * v[j].y) + (v[j].z * v[j].z + v[j].w * v[j].w);
        const float rstd = 1.0f / sqrtf(wave_sum(ss) * (1.0f / D) + EPS);
        v4u* o16 = (v4u*)(dst + (size_t)m * D) + C.lane; v2u* o8 = (v2u*)((OUTM == 3 ? dst8 : (unsigned char*)dst) + (size_t)m * D) + C.lane;
#pragma unroll
        for (int j = 0; j < 8; ++j) v[j] = v[j] * rstd * A[j] + B[j];
        if (OUTM >= 2) { float am = 0.f;
#pragma unroll
            for (int j = 0; j < 8; ++j) am = fmaxf(am, fmaxf(fmaxf(fabsf(v[j].x), fabsf(v[j].y)), fmaxf(fabsf(v[j].z), fabsf(v[j].w))));
            am = fmaxf(wave_max(am), 1e-20f); const float qi = 127.0f / am; if (C.lane == 0) sa[m] = am * (1.0f / 127.0f);
#pragma unroll
            for (int g = 0; g < 4; ++g) { v2u w; w.x = pack4_i8(v[2 * g].x * qi, v[2 * g].y * qi, v[2 * g].z * qi, v[2 * g].w * qi); w.y = pack4_i8(v[2 * g + 1].x * qi, v[2 * g + 1].y * qi, v[2 * g + 1].z * qi, v[2 * g + 1].w * qi); o8[64 * g] = w; } }
        if (OUTM == 1) {
#pragma unroll
            for (int g = 0; g < 4; ++g) { v2u w; w.x = pg8::cvt4_fp8(v[2 * g].x, v[2 * g].y, v[2 * g].z, v[2 * g].w); w.y = pg8::cvt4_fp8(v[2 * g + 1].x, v[2 * g + 1].y, v[2 * g + 1].z, v[2 * g + 1].w); o8[64 * g] = w; } }
        if (OUTM == 0 || OUTM == 3) {
#pragma unroll
            for (int g = 0; g < 4; ++g) { v4u w; w.x = pk2(v[2 * g].x, v[2 * g].y); w.y = pk2(v[2 * g].z, v[2 * g].w); w.z = pk2(v[2 * g + 1].x, v[2 * g + 1].y); w.w = pk2(v[2 * g + 1].z, v[2 * g + 1].w); o16[64 * g] = w; } }
        if (GATES) {
#pragma unroll 1
            for (int g = 0; g < 8; ++g) { float p = 0.f;
#pragma unroll
                for (int j = 0; j < 8; ++j) { const f32x4 w = *(const LAS f32x4*)(WG + g * D + 512 * (j >> 1) + 256 * (j & 1) + 4 * C.lane); p += (v[j].x * w.x + v[j].y * w.y) + (v[j].z * w.z + v[j].w * w.w); }
                p = wave_sum(p); if (C.lane == g) gates[(size_t)m * 8 + g] = p + gate_b[g]; } }
    }
    if (GATES) wg_sync();
}
DI void final_norm(const bf16* xb, float* x, const float* gain, const Ctx& C) {
    f32x4 A[8];
#pragma unroll
    for (int j = 0; j < 8; ++j) A[j] = *(const f32x4*)(gain + 8 * C.lane + 512 * (j >> 1) + 4 * (j & 1));
    for (int m = C.gw; m < M; m += C.ngw) {
        f32x4* xr = (f32x4*)(x + (size_t)m * D) + 2 * C.lane; const v4u* xs = (const v4u*)(xb + (size_t)m * D) + C.lane; f32x4 v[8]; float ss = 0.f;
#pragma unroll
        for (int g = 0; g < 4; ++g) { const v4u r = xs[64 * g]; v[2 * g] = (f32x4){bflo(r.x), bfhi(r.x), bflo(r.y), bfhi(r.y)}; v[2 * g + 1] = (f32x4){bflo(r.z), bfhi(r.z), bflo(r.w), bfhi(r.w)}; }
#pragma unroll
        for (int j = 0; j < 8; ++j) ss += (v[j].x * v[j].x + v[j].y * v[j].y) + (v[j].z * v[j].z + v[j].w * v[j].w);
        const float rstd = 1.0f / sqrtf(wave_sum(ss) * (1.0f / D) + EPS);
#pragma unroll
        for (int j = 0; j < 8; ++j) __builtin_nontemporal_store(v[j] * rstd * A[j], xr + 128 * (j >> 1) + (j & 1));
    }
}

DI void conv_phase(const bf16* PROJ, const float* cw  , bf16* YCAT, const Ctx& C) {
    constexpr int TOT = (M / 4) * 128; const int stride = C.G * NT;
    for (int it = C.bid * NT + C.tid; it < TOT; it += stride) {
        const int m0 = (it >> 7) * 4, ch = (it & 127) * 8; const bool head = (m0 & (SEQ - 1)) == 0;
        v4u gc[6], xb[6], gb[4];
#pragma unroll
        for (int r = 0; r < 6; ++r) { const int mm = (head && r < 2) ? m0 : m0 - 2 + r; const bf16* rp = PROJ + (size_t)mm * NIN; gc[r] = *(const v4u*)(rp + 4096 + ch); xb[r] = *(const v4u*)(rp + 5120 + ch); }
#pragma unroll
        for (int r = 0; r < 4; ++r) gb[r] = *(const v4u*)(PROJ + (size_t)(m0 + r) * NIN + 3072 + ch);
        f32x4 w[3][2];
#pragma unroll
        for (int j = 0; j < 3; ++j) { w[j][0] = *(const f32x4*)(cw + j * 1024 + ch); w[j][1] = *(const f32x4*)(cw + j * 1024 + ch + 4); }
        float pr[6][8];
#pragma unroll
        for (int r = 0; r < 6; ++r) { const bool ok = !(head && r < 2);
            pr[r][0] = ok ? bflo(gc[r].x) * bflo(xb[r].x) : 0.f; pr[r][1] = ok ? bfhi(gc[r].x) * bfhi(xb[r].x) : 0.f; pr[r][2] = ok ? bflo(gc[r].y) * bflo(xb[r].y) : 0.f; pr[r][3] = ok ? bfhi(gc[r].y) * bfhi(xb[r].y) : 0.f;
            pr[r][4] = ok ? bflo(gc[r].z) * bflo(xb[r].z) : 0.f; pr[r][5] = ok ? bfhi(gc[r].z) * bfhi(xb[r].z) : 0.f; pr[r][6] = ok ? bflo(gc[r].w) * bflo(xb[r].w) : 0.f; pr[r][7] = ok ? bfhi(gc[r].w) * bfhi(xb[r].w) : 0.f; }
#pragma unroll
        for (int r = 0; r < 4; ++r) { float acc[8];
#pragma unroll
            for (int i = 0; i < 8; ++i) { acc[i] = 0.f;
#pragma unroll
                for (int j = 0; j < 3; ++j) acc[i] += w[j][i >> 2][i & 3] * pr[r + j][i]; }
            const v4u g = gb[r]; v4u o; o.x = pk2(acc[0] * bflo(g.x), acc[1] * bfhi(g.x)); o.y = pk2(acc[2] * bflo(g.y), acc[3] * bfhi(g.y)); o.z = pk2(acc[4] * bflo(g.z), acc[5] * bfhi(g.z)); o.w = pk2(acc[6] * bflo(g.w), acc[7] * bfhi(g.w));
            *(v4u*)(YCAT + (size_t)(m0 + r) * D + 1024 + ch) = o; }
    }
}
DI void moba_gate_unit(const bf16* PROJ, const float* kacc, unsigned* CNT, unsigned* LIST, int b, int h, int j, const Ctx& C) {
    constexpr int KMH = 0, KML = 8704, PITCH = 272;
    LAS unsigned char* lds = C.lds;
    const int l31 = C.lane & 31, h2 = C.lane >> 5;
    const int t = j * 256 + 32 * C.wave + l31; const size_t m = (size_t)b * SEQ + t; const int bh = b * 8 + h;
    { const int n = C.tid >> 4, dc = C.tid & 15; const float* kp = kacc + (size_t)(b * 32 + n) * 1024 + 128 * h + 8 * dc; const f32x4 x0 = *(const f32x4*)kp * (1.0f / 256.0f), x1 = *(const f32x4*)(kp + 4) * (1.0f / 256.0f);
      v4u hi; hi.x = pk2(x0.x, x0.y); hi.y = pk2(x0.z, x0.w); hi.z = pk2(x1.x, x1.y); hi.w = pk2(x1.z, x1.w);
      v4u lo; lo.x = pk2(x0.x - bflo(hi.x), x0.y - bfhi(hi.x)); lo.y = pk2(x0.z - bflo(hi.y), x0.w - bfhi(hi.y)); lo.z = pk2(x1.x - bflo(hi.z), x1.y - bfhi(hi.z)); lo.w = pk2(x1.z - bflo(hi.w), x1.w - bfhi(hi.w));
      *(LAS v4u*)(lds + KMH + n * PITCH + dc * 16) = hi; *(LAS v4u*)(lds + KML + n * PITCH + dc * 16) = lo; }
    LAS unsigned* cntl = (LAS unsigned*)(lds + 17408); LAS unsigned* basel = cntl + 32;
    if (C.tid < 32) cntl[C.tid] = 0u;
    bf16x8 Q[8];
#pragma unroll
    for (int ks = 0; ks < 8; ++ks) Q[ks] = *(const bf16x8*)(PROJ + m * NIN + 128 * h + 16 * ks + 8 * h2);
    wg_sync();
    f32x16 g; ZERO16(g);
#pragma unroll
    for (int ks = 0; ks < 8; ++ks) { const int kb = (16 * ks + 8 * h2) * 2; const bf16x8 Ah = *(const LAS bf16x8*)(lds + KMH + l31 * PITCH + kb), Al = *(const LAS bf16x8*)(lds + KML + l31 * PITCH + kb);
        g = mfma32(Ah, Q[ks], g); g = mfma32(Al, Q[ks], g); }
#pragma unroll
    for (int i = 0; i < 16; ++i) if (crow(i, h2) >= j) g[i] = -INFINITY;
    int seln[3]; unsigned lpos[3];
#pragma unroll
    for (int r = 0; r < 3; ++r) { float best = -INFINITY; int bidx = 99; seln[r] = -1; lpos[r] = 0u;
#pragma unroll
        for (int i = 0; i < 16; ++i) if (g[i] > best) { best = g[i]; bidx = crow(i, h2); }
        const float pb = __shfl_xor(best, 32); const int pi = __shfl_xor(bidx, 32);
        if (pb > best || (pb == best && pi < bidx)) { best = pb; bidx = pi; }
        if (best > -1e37f) { seln[r] = bidx;
            if (h2 == 0) lpos[r] = __hip_atomic_fetch_add(cntl + bidx, 1u, __ATOMIC_RELAXED, __HIP_MEMORY_SCOPE_WORKGROUP);
#pragma unroll
            for (int i = 0; i < 16; ++i) if (crow(i, h2) == bidx) g[i] = -INFINITY; } }
    wg_sync();
    if (C.tid < 32) { const unsigned c = cntl[C.tid]; basel[C.tid] = c ? __hip_atomic_fetch_add(CNT + bh * 32 + C.tid, c, __ATOMIC_RELAXED, __HIP_MEMORY_SCOPE_AGENT) : 0u; }
    wg_sync();
    if (h2 == 0) {
#pragma unroll
        for (int r = 0; r < 3; ++r) if (seln[r] >= 0) LIST[(size_t)(bh * 32 + seln[r]) * 8192 + basel[seln[r]] + lpos[r]] = (unsigned)t | ((unsigned)r << 16); }
    wg_sync();
}
template <bool OWN>
DI void moba_tile(LAS unsigned char* lds, const bf16* PROJ, bf16* PART, float* ML, int b, int h, int n, int t, bool valid, int slot, int nchunks, const Ctx& C) {
    constexpr int KB = 0, VB = 69632, EB = 139264, PITCH = 272;
    const int l31 = C.lane & 31, h2 = C.lane >> 5, blk = (C.lane >> 4) & 1, q = (C.lane & 15) >> 2, p = C.lane & 3;
    const size_t m = (size_t)b * SEQ + t; const int qi = t & 255;
    const float c1 = 0.08838834764831845f * 1.4426950408889634f, sl2 = exp2f(-(float)(h + 1)) * 1.4426950408889634f;
    bf16x8 Q[8];
#pragma unroll
    for (int ks = 0; ks < 8; ++ks) { const v4u r = *(const v4u*)(PROJ + m * NIN + 128 * h + 16 * ks + 8 * h2); v4u w;
        w.x = pk2(bflo(r.x) * c1, bfhi(r.x) * c1); w.y = pk2(bflo(r.y) * c1, bfhi(r.y) * c1); w.z = pk2(bflo(r.z) * c1, bfhi(r.z) * c1); w.w = pk2(bflo(r.w) * c1, bfhi(r.w) * c1); Q[ks] = __builtin_bit_cast(bf16x8, w); }
    v4u qxw = {h2 == 0 ? 0x3F803F80u : 0u, 0u, 0u, 0u}; const bf16x8 Qx = __builtin_bit_cast(bf16x8, qxw);
    f32x16 O[4];
#pragma unroll
    for (int i = 0; i < 4; ++i) ZERO16(O[i]);
    float mrun = -INFINITY, lrun = 0.f;
#pragma unroll 1
    for (int cc = 0; cc < nchunks; ++cc) {
        const int kbase = (OWN ? cc : 3 - cc) * 64;
        f32x16 S0, S1; ZERO16(S0); ZERO16(S1);
        { bf16x8 KA[9], KB2[9];
          constexpr int KDEPTH = 3;
#define MOBA_LDK(ks_) do { if ((ks_) < 8) { const int kb_ = (16 * (ks_) + 8 * h2) * 2; KA[ks_] = *(const LAS bf16x8*)(lds + KB + (kbase + l31) * PITCH + kb_); KB2[ks_] = *(const LAS bf16x8*)(lds + KB + (kbase + 32 + l31) * PITCH + kb_); } \
            else { KA[8] = *(const LAS bf16x8*)(lds + EB + (kbase + l31) * 32 + h2 * 16); KB2[8] = *(const LAS bf16x8*)(lds + EB + (kbase + 32 + l31) * 32 + h2 * 16); } } while (0)
#pragma unroll
          for (int ks = 0; ks < KDEPTH; ++ks) MOBA_LDK(ks);
          __builtin_amdgcn_sched_barrier(0);
#pragma unroll
          for (int ks = 0; ks < 9; ++ks) { if (ks + KDEPTH < 9) MOBA_LDK(ks + KDEPTH);
              if (ks < 8) { S0 = mfma32(KA[ks], Q[ks], S0); S1 = mfma32(KB2[ks], Q[ks], S1); } else { S0 = mfma32(KA[8], Qx, S0); S1 = mfma32(KB2[8], Qx, S1); }
              __builtin_amdgcn_sched_barrier(0); }
#undef MOBA_LDK
        }
        if (OWN) { const int lim = qi - kbase - 4 * h2;
#pragma unroll
            for (int i = 0; i < 16; ++i) { const int ci = (i & 3) + 8 * (i >> 2); if (ci > lim) S0[i] = -INFINITY; if (ci + 32 > lim) S1[i] = -INFINITY; } }
        float mx = fmaxf(S0[0], S1[0]);
#pragma unroll
        for (int i = 1; i < 16; ++i) mx = fmaxf(mx, fmaxf(S0[i], S1[i]));
        mx = fmaxf(mx, __shfl_xor(mx, 32));
        const float mnew = fmaxf(mrun, mx);
        if (__ballot(mnew > mrun) != 0ull) { const float alpha = __builtin_amdgcn_exp2f(mrun - mnew); lrun *= alpha;
#pragma unroll
            for (int et = 0; et < 4; ++et) O[et] = O[et] * alpha; }
        mrun = mnew; float ps = 0.f;
#pragma unroll
        for (int i = 0; i < 16; ++i) { S0[i] = __builtin_amdgcn_exp2f(S0[i] - mnew); S1[i] = __builtin_amdgcn_exp2f(S1[i] - mnew); ps += S0[i] + S1[i]; }
        lrun += ps;
#pragma unroll
        for (int s2 = 0; s2 < 4; ++s2) { v4u pw;
            if (s2 < 2) { pw.x = pk2(S0[8 * s2], S0[8 * s2 + 1]); pw.y = pk2(S0[8 * s2 + 2], S0[8 * s2 + 3]); pw.z = pk2(S0[8 * s2 + 4], S0[8 * s2 + 5]); pw.w = pk2(S0[8 * s2 + 6], S0[8 * s2 + 7]); }
            else { pw.x = pk2(S1[8 * s2 - 16], S1[8 * s2 - 15]); pw.y = pk2(S1[8 * s2 - 14], S1[8 * s2 - 13]); pw.z = pk2(S1[8 * s2 - 12], S1[8 * s2 - 11]); pw.w = pk2(S1[8 * s2 - 10], S1[8 * s2 - 9]); }
            const bf16x8 Pf = __builtin_bit_cast(bf16x8, pw); const int r0 = kbase + 16 * s2 + 4 * h2;
#pragma unroll
            for (int et = 0; et < 4; ++et) { const bf16x8 A = tr_frag(lds + VB, PITCH, r0, r0 + 8, (32 * et + 16 * blk + 4 * p) * 2, q); O[et] = mfma32(A, Pf, O[et]); } }
    }
    const float ltot = lrun + __shfl_xor(lrun, 32), inv = 1.0f / ltot;
    if (valid) { const size_t prow = ((size_t)(b * 8 + h) * 8192 + t) * 4 + slot; bf16* op = PART + prow * 128;
#pragma unroll
        for (int et = 0; et < 4; ++et)
#pragma unroll
            for (int g2 = 0; g2 < 4; ++g2) { v2u o; o.x = pk2(O[et][4 * g2] * inv, O[et][4 * g2 + 1] * inv); o.y = pk2(O[et][4 * g2 + 2] * inv, O[et][4 * g2 + 3] * inv); *(v2u*)(op + 32 * et + 8 * g2 + 4 * h2) = o; }
        if (h2 == 0) { ML[prow * 2] = mrun - sl2 * (float)(t - 256 * n); ML[prow * 2 + 1] = ltot; } }
}
DI void moba_work_phase(const bf16* PROJ, const unsigned* CNT, const unsigned* LIST, unsigned* QCTR, bf16* PART, float* ML, const Ctx& C) {
    constexpr int NA = 31 * 64, NU = NA + 16, PITCH = 272;
    LAS unsigned char* lds = C.lds; volatile LAS unsigned* nxt = (volatile LAS unsigned*)(lds + 147456);
    if (C.tid == 0) nxt[0] = __hip_atomic_fetch_add(QCTR, 1u, __ATOMIC_RELAXED, __HIP_MEMORY_SCOPE_AGENT);
    for (;;) {
        wg_sync();
        const int ui = (int)nxt[0];
        wg_sync();
        if (ui >= NU) break;
        unsigned pre = 0u; if (C.tid == 0) pre = __hip_atomic_fetch_add(QCTR, 1u, __ATOMIC_RELAXED, __HIP_MEMORY_SCOPE_AGENT);
        int b, h, n, tile0 = 0, tile1 = 0; unsigned cnt = 0; bool own = true;
        if (ui < NA) { n = ui >> 6; const int bh = (ui >> 2) & 15, part = ui & 3; b = bh >> 3; h = bh & 7; cnt = CNT[bh * 32 + n]; const int ntiles = (int)((cnt + 31u) >> 5), tp4 = (ntiles + 3) >> 2, tp = (tp4 + 7) & ~7;     tile0 = tp * part; tile1 = tile0 + tp < ntiles ? tile0 + tp : ntiles; own = part == 0; if (!own && tile0 >= ntiles) { if (C.tid == 0) nxt[0] = pre; continue; } }
        else { const int bh = ui - NA; n = 31; b = bh >> 3; h = bh & 7; }
        { const size_t row0 = (size_t)b * SEQ + n * 256;
#pragma unroll
          for (int i = 0; i < 8; ++i) { const int idx = C.tid + NT * i; const bf16* rp = PROJ + (row0 + (idx >> 4)) * NIN + 128 * h + 8 * (idx & 15);
              *(LAS v4u*)(lds + (idx >> 4) * PITCH + (idx & 15) * 16) = *(const v4u*)(rp + 1024); *(LAS v4u*)(lds + 69632 + (idx >> 4) * PITCH + (idx & 15) * 16) = *(const v4u*)(rp + 2048); }
          if (C.tid < 256) { const float x = exp2f(-(float)(h + 1)) * 1.4426950408889634f * (float)C.tid; const unsigned hi = pk2(x, 0.f) & 0xffffu; const unsigned lo = pk2(x - bflo(hi), 0.f) & 0xffffu;
              v4u e0 = {hi | (lo << 16), 0u, 0u, 0u}, e1 = {0u, 0u, 0u, 0u}; *(LAS v4u*)(lds + 139264 + C.tid * 32) = e0; *(LAS v4u*)(lds + 139264 + C.tid * 32 + 16) = e1; } }
        wg_sync();
        { const unsigned* lp = LIST + (size_t)((b * 8 + h) * 32 + n) * 8192;
          for (int tile = tile0 + C.wave; tile < tile1; tile += 8) { const unsigned e = 32u * tile + (C.lane & 31); const bool valid = e < cnt; const unsigned ent = lp[valid ? e : 32u * tile];
              moba_tile<false>(lds, PROJ, PART, ML, b, h, n, (int)(ent & 0xffffu), valid, (int)(ent >> 16), 4, C); } }
        if (own) moba_tile<true>(lds, PROJ, PART, ML, b, h, n, n * 256 + 32 * C.wave + (C.lane & 31), true, 3, (32 * C.wave + 31) / 64 + 1, C);
        if (C.tid == 0) nxt[0] = pre;
    }
}
DI void moba_merge_phase(const bf16* PART, const float* ML, bf16* YCAT, const Ctx& C) {
    constexpr int TOT = 131072 * 16; const int stride = C.G * NT;
    for (int it0 = C.bid * NT + C.tid; it0 < TOT; it0 += 4 * stride) {
        f32x4 ml[4][2]; v4u pv[4][4];
#pragma unroll
        for (int k = 0; k < 4; ++k) { const int it = it0 + k * stride, itc = it < TOT ? it : TOT - 1, row = itc >> 4, ec = (itc & 15) * 8;
            ml[k][0] = __builtin_nontemporal_load((const f32x4*)(ML + (size_t)row * 8)); ml[k][1] = __builtin_nontemporal_load((const f32x4*)(ML + (size_t)row * 8 + 4));
#pragma unroll
            for (int s = 0; s < 4; ++s) pv[k][s] = __builtin_nontemporal_load((const v4u*)(PART + ((size_t)row * 4 + s) * 128 + ec)); }
#pragma unroll
        for (int k = 0; k < 4; ++k) { const int it = it0 + k * stride, itc = it < TOT ? it : TOT - 1, row = itc >> 4, ec = (itc & 15) * 8, t = row & 8191, bh = row >> 13, j = t >> 8, nsel = j < 3 ? j : 3;
            float mm[4], ll[4];
            mm[0] = nsel > 0 ? ml[k][0].x : -INFINITY; ll[0] = nsel > 0 ? ml[k][0].y : 0.f; mm[1] = nsel > 1 ? ml[k][0].z : -INFINITY; ll[1] = nsel > 1 ? ml[k][0].w : 0.f;
            mm[2] = nsel > 2 ? ml[k][1].x : -INFINITY; ll[2] = nsel > 2 ? ml[k][1].y : 0.f; mm[3] = ml[k][1].z; ll[3] = ml[k][1].w;
            const float Mx = fmaxf(fmaxf(mm[0], mm[1]), fmaxf(mm[2], mm[3]));
            float acc[8], W = 0.f;
#pragma unroll
            for (int i = 0; i < 8; ++i) acc[i] = 0.f;
#pragma unroll
            for (int s = 0; s < 4; ++s) { const bool ok = (s == 3) || (s < nsel); const float w = ok ? ll[s] * __builtin_amdgcn_exp2f(mm[s] - Mx) : 0.f; W += w;
                v4u v = pv[k][s]; if (!ok) v = (v4u){0u, 0u, 0u, 0u};
                acc[0] += w * bflo(v.x); acc[1] += w * bfhi(v.x); acc[2] += w * bflo(v.y); acc[3] += w * bfhi(v.y); acc[4] += w * bflo(v.z); acc[5] += w * bfhi(v.z); acc[6] += w * bflo(v.w); acc[7] += w * bfhi(v.w); }
            const float inv = 1.0f / W; v4u o; o.x = pk2(acc[0] * inv, acc[1] * inv); o.y = pk2(acc[2] * inv, acc[3] * inv); o.z = pk2(acc[4] * inv, acc[5] * inv); o.w = pk2(acc[6] * inv, acc[7] * inv);
            if (it < TOT) *(v4u*)(YCAT + ((size_t)(bh >> 3) * SEQ + t) * D + 128 * (bh & 7) + ec) = o; }
    }
}

DI void rg_step1_unit(const bf16* PROJ, const bf16* waT, const bf16* wxT, const float* cw, const float* cb, const float* ba, const float* bx, const float* lam,
                      bf16* HLOC, bf16* PCUM, float* SUMM, int b, int g, int seg, const Ctx& C) {
    constexpr int WA = 0, WX = 34816, XCB = 69632, XCF = 87040, AA = 119808;
    LAS unsigned char* lds = C.lds;
#pragma unroll
    for (int i = 0; i < 4; ++i) { const int idx = C.tid + NT * i, r = idx >> 4, ch = idx & 15;
        *(LAS v4u*)(lds + WA + r * 272 + ch * 16) = *(const v4u*)(waT + g * 16384 + r * 128 + ch * 8); *(LAS v4u*)(lds + WX + r * 272 + ch * 16) = *(const v4u*)(wxT + g * 16384 + r * 128 + ch * 8); }
    const int ct = C.wave & 3, rt = C.wave >> 2, l31 = C.lane & 31, hh = C.lane >> 5, cj = 32 * ct + l31, cg = g * 128 + cj;
    const float bac = ba[cg], bxc = bx[cg], spc = log1pf(fexp(-lam[cg]));
    LAS float* xcf = (LAS float*)(lds + XCF); LAS float* aa = (LAS float*)(lds + AA);
    float hl = 0.f, P = 1.f;
    v4u xr[4][2];
#define RG_PREFETCH(st_) do { int tl_ = C.tid; asm volatile("" : "+v"(tl_)); const int t_ = seg * 512 + (st_) * 64 + (tl_ >> 3); \
        _Pragma("unroll") for (int j_ = 0; j_ < 4; ++j_) { const int tt_ = t_ - 3 + j_; const bf16* rp_ = PROJ + ((size_t)b * SEQ + (tt_ < 0 ? 0 : tt_)) * NIN + g * 128 + 16 * (tl_ & 7); xr[j_][0] = *(const v4u*)rp_; xr[j_][1] = *(const v4u*)(rp_ + 8); } } while (0)
    LAS float* cwl = (LAS float*)(lds + 152576);
    for (int i = C.tid; i < 640; i += NT) cwl[i] = i < 512 ? cw[(i >> 7) * 1024 + g * 128 + (i & 127)] : cb[g * 128 + (i - 512)];
    RG_PREFETCH(0);
    wg_sync();
    for (int st = 0; st < 8; ++st) {
        const int tbase = seg * 512 + st * 64;
        { const int r = C.tid >> 3, cc = C.tid & 7, t = tbase + r, c0 = g * 128 + 16 * cc; float xc[16];
#pragma unroll
          for (int i = 0; i < 4; ++i) { const f32x4 v = *(const LAS f32x4*)(cwl + 512 + 16 * cc + 4 * i); xc[4 * i] = v.x; xc[4 * i + 1] = v.y; xc[4 * i + 2] = v.z; xc[4 * i + 3] = v.w; }
#pragma unroll
          for (int j = 0; j < 4; ++j) { const int tt = t - 3 + j; if (tt < 0) continue;
              const v4u x0 = xr[j][0], x1 = xr[j][1];
              const LAS float* wp = cwl + j * 128 + 16 * cc; const f32x4 w0 = *(const LAS f32x4*)wp, w1 = *(const LAS f32x4*)(wp + 4), w2 = *(const LAS f32x4*)(wp + 8), w3 = *(const LAS f32x4*)(wp + 12);
              xc[0] += w0.x * bflo(x0.x); xc[1] += w0.y * bfhi(x0.x); xc[2] += w0.z * bflo(x0.y); xc[3] += w0.w * bfhi(x0.y); xc[4] += w1.x * bflo(x0.z); xc[5] += w1.y * bfhi(x0.z); xc[6] += w1.z * bflo(x0.w); xc[7] += w1.w * bfhi(x0.w);
              xc[8] += w2.x * bflo(x1.x); xc[9] += w2.y * bfhi(x1.x); xc[10] += w2.z * bflo(x1.y); xc[11] += w2.w * bfhi(x1.y); xc[12] += w3.x * bflo(x1.z); xc[13] += w3.y * bfhi(x1.z); xc[14] += w3.z * bflo(x1.w); xc[15] += w3.w * bfhi(x1.w); }
#pragma unroll
          for (int i = 0; i < 4; ++i) *(LAS f32x4*)(xcf + r * 128 + 16 * cc + 4 * i) = (f32x4){xc[4 * i], xc[4 * i + 1], xc[4 * i + 2], xc[4 * i + 3]};
          v4u p0, p1; p0.x = pk2(xc[0], xc[1]); p0.y = pk2(xc[2], xc[3]); p0.z = pk2(xc[4], xc[5]); p0.w = pk2(xc[6], xc[7]); p1.x = pk2(xc[8], xc[9]); p1.y = pk2(xc[10], xc[11]); p1.z = pk2(xc[12], xc[13]); p1.w = pk2(xc[14], xc[15]);
          *(LAS v4u*)(lds + XCB + r * 272 + cc * 32) = p0; *(LAS v4u*)(lds + XCB + r * 272 + cc * 32 + 16) = p1; }
        wg_sync();
        if (st < 7) RG_PREFETCH(st + 1);
        f32x16 ar, ai; ZERO16(ar); ZERO16(ai);
#pragma unroll
        for (int ks = 0; ks < 8; ++ks) { const int kb = (16 * ks + 8 * hh) * 2;
            const bf16x8 A = *(const LAS bf16x8*)(lds + XCB + (32 * rt + l31) * 272 + kb), Br = *(const LAS bf16x8*)(lds + WA + cj * 272 + kb), Bi = *(const LAS bf16x8*)(lds + WX + cj * 272 + kb);
            ar = mfma32(A, Br, ar); ai = mfma32(A, Bi, ai); }
#pragma unroll
        for (int i = 0; i < 16; ++i) { const int tr = 32 * rt + crow(i, hh); const float xv = xcf[tr * 128 + cj];
            const float r_ = sigmoid_f(ar[i] + bac), ig = sigmoid_f(ai[i] + bxc), av = fexp(-8.0f * r_ * spc), mult = __builtin_amdgcn_sqrtf(fmaxf(1.0f - av * av, 0.f));
            xcf[tr * 128 + cj] = mult * ig * xv; aa[tr * 128 + cj] = av; }
        wg_sync();
        if (C.tid < 128) {
#pragma unroll 2
            for (int r0 = 0; r0 < 64; r0 += 8) { float av[8], uv[8];
#pragma unroll
                for (int i = 0; i < 8; ++i) { av[i] = aa[(r0 + i) * 128 + C.tid]; uv[i] = xcf[(r0 + i) * 128 + C.tid]; }
#pragma unroll
                for (int i = 0; i < 8; ++i) { hl = av[i] * hl + uv[i]; P *= av[i]; uv[i] = hl; av[i] = P; }
#pragma unroll
                for (int i = 0; i < 8; ++i) { xcf[(r0 + i) * 128 + C.tid] = uv[i]; aa[(r0 + i) * 128 + C.tid] = av[i]; } } }
        wg_sync();
#pragma unroll
        for (int i = 0; i < 4; ++i) { const int idx = C.tid + NT * i, r = idx >> 5, c4 = (idx & 31) * 4; const size_t o = ((size_t)b * SEQ + tbase + r) * 1024 + g * 128 + c4;
            const f32x4 hv = *(const LAS f32x4*)(xcf + r * 128 + c4), pv = *(const LAS f32x4*)(aa + r * 128 + c4); v2u ho, po; ho.x = pk2(hv.x, hv.y); ho.y = pk2(hv.z, hv.w); po.x = pk2(pv.x, pv.y); po.y = pk2(pv.z, pv.w);
            *(v2u*)(HLOC + o) = ho; *(v2u*)(PCUM + o) = po; }
        wg_sync();
    }
#undef RG_PREFETCH
    if (C.tid < 128) { float* sp = SUMM + (size_t)((b * 8 + g) * 16 + seg) * 256; sp[C.tid] = P; sp[128 + C.tid] = hl; }
}
template <bool OUT8>
DI void rg_step2_unit(const bf16* PROJ, const bf16* HLOC, const bf16* PCUM, const float* SUMM, bf16* YCAT, int b, int g, int seg, const Ctx& C) {
    LAS float* carry = (LAS float*)C.lds;
    if (C.tid < 128) { float pa[15], ha[15];
#pragma unroll
        for (int s = 0; s < 15; ++s) { const float* sp = SUMM + (size_t)((b * 8 + g) * 16 + (s < seg ? s : 0)) * 256; pa[s] = sp[C.tid]; ha[s] = sp[128 + C.tid]; }
        float hc = 0.f;
#pragma unroll
        for (int s = 0; s < 15; ++s) hc = s < seg ? pa[s] * hc + ha[s] : hc;
        carry[C.tid] = hc; }
    wg_sync();
#pragma unroll 1
    for (int i0 = 0; i0 < 16; i0 += 8) { v4u hb[8], pb[8], gr[8];
#pragma unroll
        for (int k = 0; k < 8; ++k) { const int it = C.tid + NT * (i0 + k), r = it >> 4, c8 = (it & 15) * 8; const size_t mrow = (size_t)b * SEQ + seg * 512 + r, idx = mrow * 1024 + g * 128 + c8;
            hb[k] = __builtin_nontemporal_load((const v4u*)(HLOC + idx)); pb[k] = __builtin_nontemporal_load((const v4u*)(PCUM + idx)); gr[k] = *(const v4u*)(PROJ + mrow * NIN + 1024 + g * 128 + c8); }
#pragma unroll
        for (int k = 0; k < 8; ++k) { const int it = C.tid + NT * (i0 + k), r = it >> 4, c8 = (it & 15) * 8; const size_t mrow = (size_t)b * SEQ + seg * 512 + r;
            const f32x4 cy0 = *(const LAS f32x4*)(carry + c8), cy1 = *(const LAS f32x4*)(carry + c8 + 4); const v4u h_ = hb[k], p_ = pb[k], g_ = gr[k];
            const float y0 = (bflo(h_.x) + bflo(p_.x) * cy0.x) * gelu_tanh(bflo(g_.x)), y1 = (bfhi(h_.x) + bfhi(p_.x) * cy0.y) * gelu_tanh(bfhi(g_.x)), y2 = (bflo(h_.y) + bflo(p_.y) * cy0.z) * gelu_tanh(bflo(g_.y)), y3 = (bfhi(h_.y) + bfhi(p_.y) * cy0.w) * gelu_tanh(bfhi(g_.y));
            const float y4 = (bflo(h_.z) + bflo(p_.z) * cy1.x) * gelu_tanh(bflo(g_.z)), y5 = (bfhi(h_.z) + bfhi(p_.z) * cy1.y) * gelu_tanh(bfhi(g_.z)), y6 = (bflo(h_.w) + bflo(p_.w) * cy1.z) * gelu_tanh(bflo(g_.w)), y7 = (bfhi(h_.w) + bfhi(p_.w) * cy1.w) * gelu_tanh(bfhi(g_.w));
            if (OUT8) { v2u o; o.x = pg8::cvt4_fp8(y0, y1, y2, y3); o.y = pg8::cvt4_fp8(y4, y5, y6, y7); *(v2u*)((unsigned char*)YCAT + mrow * D + g * 128 + c8) = o; }
            else { v4u o; o.x = pk2(y0, y1); o.y = pk2(y2, y3); o.z = pk2(y4, y5); o.w = pk2(y6, y7); *(v4u*)(YCAT + mrow * D + g * 128 + c8) = o; } } }
    wg_sync();
}
DI void mlstm_scalars(const float* GATES, LAS float* sb, int mbase, int hh, const Ctx& C) {
    float lf = 0.f, ip = 0.f;
    if (C.tid < 256) { ip = GATES[(size_t)(mbase + C.tid) * 8 + hh]; lf = log_sigmoid_f(GATES[(size_t)(mbase + C.tid) * 8 + 4 + hh]); }
    float v = lf;
#pragma unroll
    for (int o = 1; o < 64; o <<= 1) { const float n = __shfl_up(v, o); if (C.lane >= o) v += n; }
    LAS float* wt = sb + 768;
    if (C.tid < 256 && C.lane == 63) wt[C.wave] = v;
    wg_sync();
    float e = -INFINITY;
    if (C.tid < 256) { float pre = 0.f; for (int w = 0; w < C.wave; ++w) pre += wt[w]; v += pre; sb[C.tid] = v; e = ip - v; sb[256 + C.tid] = e; }
    float cm = e;
#pragma unroll
    for (int o = 1; o < 64; o <<= 1) { const float n = __shfl_up(cm, o); if (C.lane >= o) cm = fmaxf(cm, n); }
    if (C.tid < 256 && C.lane == 63) wt[8 + C.wave] = cm;
    wg_sync();
    if (C.tid < 256) { float pre = -INFINITY; for (int w = 0; w < C.wave; ++w) pre = fmaxf(pre, wt[8 + w]); sb[512 + C.tid] = fmaxf(cm, pre); }
    wg_sync();
}
DI void mlstm_x1_unit(const bf16* PROJ, const float* GATES, bf16* USTATE, float* NST, float* CH, int b, int hh, int c, const Ctx& C) {
    constexpr int KS = 0, VS = 33792, SB = 67584, WV = 71680, PITCH = 528;
    LAS unsigned char* lds = C.lds; LAS float* sb = (LAS float*)(lds + SB); LAS float* wv = (LAS float*)(lds + WV);
    const int mbase = b * SEQ + c * 256, chain = b * 4 + hh;
    mlstm_scalars(GATES, sb, mbase, hh, C);
    const float gl = sb[767];
    if (C.tid < 256) wv[C.tid] = fexp(sb[256 + C.tid] - gl);
    if (C.tid == 0) { CH[(chain * 32 + c) * 2] = sb[255]; CH[(chain * 32 + c) * 2 + 1] = gl; }
    wg_sync();
    const int l31 = C.lane & 31, h2 = C.lane >> 5, blk = (C.lane >> 4) & 1, q = (C.lane & 15) >> 2, p = C.lane & 3;
    f32x16 acc[8];
#pragma unroll
    for (int i = 0; i < 8; ++i) ZERO16(acc[i]);
    float nacc = 0.f;
    for (int sbk = 0; sbk < 4; ++sbk) {
#pragma unroll
        for (int i = 0; i < 4; ++i) { const int idx = C.tid + NT * i, r = idx >> 5, ch = idx & 31; const bf16* rp = PROJ + (size_t)(mbase + sbk * 64 + r) * NIN + 256 * hh + 8 * ch;
            *(LAS v4u*)(lds + KS + r * PITCH + ch * 16) = *(const v4u*)(rp + 3072);
            const v4u vv = *(const v4u*)(rp + 4096); const float w = wv[sbk * 64 + r]; v4u o;
            o.x = pk2(bflo(vv.x) * w, bfhi(vv.x) * w); o.y = pk2(bflo(vv.y) * w, bfhi(vv.y) * w); o.z = pk2(bflo(vv.z) * w, bfhi(vv.z) * w); o.w = pk2(bflo(vv.w) * w, bfhi(vv.w) * w);
            *(LAS v4u*)(lds + VS + r * PITCH + ch * 16) = o; }
        wg_sync();
        if (C.tid < 256) {
#pragma unroll 8
            for (int r = 0; r < 64; ++r) nacc += wv[sbk * 64 + r] * bf2f(*(const LAS bf16*)(lds + KS + r * PITCH + C.tid * 2)); }
#pragma unroll
        for (int ks = 0; ks < 4; ++ks) { const int r0 = 16 * ks + 8 * h2;
            const bf16x8 A = tr_frag(lds + KS, PITCH, r0, r0 + 4, (32 * C.wave + 16 * blk + 4 * p) * 2, q);
#pragma unroll
            for (int et = 0; et < 8; ++et) { const bf16x8 B = tr_frag(lds + VS, PITCH, r0, r0 + 4, (32 * et + 16 * blk + 4 * p) * 2, q); acc[et] = mfma32(A, B, acc[et]); } }
        wg_sync();
    }
    bf16* Up = USTATE + (size_t)(chain * 32 + c) * 65536;
#pragma unroll
    for (int et = 0; et < 8; ++et)
#pragma unroll
        for (int i = 0; i < 16; i += 2) { float a0 = acc[et][i], a1 = acc[et][i + 1]; asm volatile("" : "+v"(a0), "+v"(a1));
            const float mine = (C.lane & 1) ? a1 : a0, give = (C.lane & 1) ? a0 : a1; const float got = __shfl_xor(give, 1);
            const int row = 32 * C.wave + crow(i + (C.lane & 1), h2), col = 32 * et + (l31 & ~1);
            *(unsigned*)(Up + (size_t)row * 256 + col) = (C.lane & 1) ? pk2(got, mine) : pk2(mine, got); }
    if (C.tid < 256) NST[(size_t)(chain * 32 + c) * 256 + C.tid] = nacc;
}
DI void mlstm_x2(bf16* USTATE, float* NST, const float* CH, float* CHS, const Ctx& C) {
    for (int w = C.bid * NT + C.tid; w < 8 * 8192 + 8 * 64; w += C.G * NT) {
        const bool isn = w >= 8 * 8192; const int ww = isn ? w - 8 * 8192 : w; const int chain = isn ? ww >> 6 : ww >> 13;
        float Boff = 0.f, R = 0.f;
        if (isn) { float* base = NST + (size_t)chain * 32 * 256 + (ww & 63) * 4; f32x4 st = {0.f, 0.f, 0.f, 0.f};
#pragma unroll 4
            for (int c = 0; c < 32; ++c) { const float Bsum = CH[(chain * 32 + c) * 2], gl = CH[(chain * 32 + c) * 2 + 1]; const float Rn = fmaxf(R, gl - Boff), dec = fexp(R - Rn), wu = fexp(gl - Boff - Rn);
                f32x4* pp = (f32x4*)(base + c * 256); const f32x4 u = *pp; *pp = st; st = dec * st + wu * u; Boff += Bsum; R = Rn; } }
        else { bf16* base = USTATE + (size_t)chain * 32 * 65536 + (ww & 8191) * 8; float st[8];
#pragma unroll
            for (int i = 0; i < 8; ++i) st[i] = 0.f;
#pragma unroll 4
            for (int c = 0; c < 32; ++c) { const float Bsum = CH[(chain * 32 + c) * 2], gl = CH[(chain * 32 + c) * 2 + 1]; const float Rn = fmaxf(R, gl - Boff), dec = fexp(R - Rn), wu = fexp(gl - Boff - Rn);
                v4u* pp = (v4u*)(base + (size_t)c * 65536); const v4u u = *pp; v4u o; o.x = pk2(st[0], st[1]); o.y = pk2(st[2], st[3]); o.z = pk2(st[4], st[5]); o.w = pk2(st[6], st[7]); *pp = o;
                st[0] = dec * st[0] + wu * bflo(u.x); st[1] = dec * st[1] + wu * bfhi(u.x); st[2] = dec * st[2] + wu * bflo(u.y); st[3] = dec * st[3] + wu * bfhi(u.y);
                st[4] = dec * st[4] + wu * bflo(u.z); st[5] = dec * st[5] + wu * bfhi(u.z); st[6] = dec * st[6] + wu * bflo(u.w); st[7] = dec * st[7] + wu * bfhi(u.w);
                if ((ww & 8191) == 0) { CHS[(chain * 32 + c) * 2] = Boff; CHS[(chain * 32 + c) * 2 + 1] = R; }
                Boff += Bsum; R = Rn; } }
    }
}
DI f32x4 mfma16(bf16x8 a, bf16x8 b, f32x4 c) { return __builtin_amdgcn_mfma_f32_16x16x32_bf16(a, b, c, 0, 0, 0); }
template <bool OUT8>
DI void mlstm_x3b_unit(const bf16* PROJ, const float* GATES, const bf16* USTATE, const float* NST, const float* CHS, bf16* YCAT, int b, int hh, int c, const Ctx& C) {
    constexpr int CS = 0, CPITCH = 272, KS = 69632, KPITCH = 528, VS = 103424, VPITCH = 272, SB = 120832, AR = 124928;
    LAS unsigned char* lds = C.lds; LAS float* sb = (LAS float*)(lds + SB); LAS float* esb = (LAS float*)(lds + AR); LAS float* Gq = esb + 256; LAS float* wint = esb + 512; LAS float* mex = esb + 768; LAS float* nh = esb + 1024; LAS float* dqa = esb + 1280;
    const int mbase = b * SEQ + c * 256, chain = b * 4 + hh;
    mlstm_scalars(GATES, sb, mbase, hh, C);
    const float Boff = CHS[(chain * 32 + c) * 2], R = CHS[(chain * 32 + c) * 2 + 1];
    if (C.tid < 256) { const float e = sb[256 + C.tid], cm = sb[512 + C.tid], bc = sb[C.tid], G = fmaxf(R, cm - Boff);
        esb[C.tid] = e - Boff; Gq[C.tid] = G; wint[C.tid] = fexp(R - G); mex[C.tid] = fexp(-(Boff + bc + G)); nh[C.tid] = NST[(size_t)(chain * 32 + c) * 256 + C.tid]; }
    wg_sync();
    const int l15 = C.lane & 15, g = C.lane >> 4, q = l15 >> 2, p = l15 & 3;
    int qt[2]; qt[0] = C.wave; qt[1] = 15 - C.wave;
    bf16x8 Q[2][8];
#pragma unroll
    for (int T = 0; T < 2; ++T) { const int t = 16 * qt[T] + l15; const size_t m = (size_t)mbase + t;
#pragma unroll
        for (int ks = 0; ks < 8; ++ks) Q[T][ks] = *(const bf16x8*)(PROJ + m * NIN + 2048 + 256 * hh + 32 * ks + 8 * g);
        float d = 0.f;
#pragma unroll
        for (int ks = 0; ks < 8; ++ks) { const f32x4 n0 = *(const LAS f32x4*)(nh + 32 * ks + 8 * g), n1 = *(const LAS f32x4*)(nh + 32 * ks + 8 * g + 4); const v4u qw = __builtin_bit_cast(v4u, Q[T][ks]);
            d += (bflo(qw.x) * n0.x + bfhi(qw.x) * n0.y) + (bflo(qw.y) * n0.z + bfhi(qw.y) * n0.w) + (bflo(qw.z) * n1.x + bfhi(qw.z) * n1.y) + (bflo(qw.w) * n1.z + bfhi(qw.w) * n1.w);
            __builtin_amdgcn_sched_barrier(0); }
        d += __shfl_xor(d, 16); d += __shfl_xor(d, 32); if (g == 0) dqa[t] = d; }
    for (int eh = 0; eh < 2; ++eh) {
        { int tl = C.tid; asm volatile("" : "+v"(tl)); const bf16* cp = USTATE + ((size_t)(chain * 32 + c) * 256 + (tl >> 4)) * 256 + 128 * eh + 8 * (tl & 15); LAS unsigned char* cd = lds + CS + (tl >> 4) * CPITCH + (tl & 15) * 16;
#pragma unroll
          for (int i0 = 0; i0 < 8; i0 += 4) { v4u cc[4];
#pragma unroll
              for (int i = 0; i < 4; ++i) cc[i] = *(const v4u*)(cp + (size_t)(i0 + i) * 32 * 256);
#pragma unroll
              for (int i = 0; i < 4; ++i) *(LAS v4u*)(cd + (i0 + i) * 32 * CPITCH) = cc[i]; } }
        v4u pk[4], pv[2];
#define X3B_PREFETCH(kb_) do { int tl_ = C.tid; asm volatile("" : "+v"(tl_)); const bf16* kp_ = PROJ + (size_t)(mbase + (kb_) * 64 + (tl_ >> 5)) * NIN + 3072 + 256 * hh + 8 * (tl_ & 31); \
        _Pragma("unroll") for (int i_ = 0; i_ < 4; ++i_) pk[i_] = *(const v4u*)(kp_ + (size_t)i_ * 16 * NIN); \
        const bf16* vp_ = PROJ + (size_t)(mbase + (kb_) * 64 + (tl_ >> 4)) * NIN + 4096 + 256 * hh + 128 * eh + 8 * (tl_ & 15); \
        _Pragma("unroll") for (int i_ = 0; i_ < 2; ++i_) pv[i_] = *(const v4u*)(vp_ + (size_t)i_ * 32 * NIN); } while (0)
        X3B_PREFETCH(0);
        wg_sync();
        f32x4 acc[2][8]; float dsum[2];
#pragma unroll
        for (int T = 0; T < 2; ++T) { dsum[T] = 0.f;
#pragma unroll
            for (int et = 0; et < 8; ++et) acc[T][et] = (f32x4){0.f, 0.f, 0.f, 0.f};
#pragma unroll
            for (int ks = 0; ks < 8; ++ks) { const int r0 = 32 * ks + 8 * g;
#pragma unroll
                for (int et = 0; et < 8; ++et) { const bf16x8 A = tr_frag(lds + CS, CPITCH, r0, r0 + 4, (16 * et + 4 * p) * 2, q); acc[T][et] = mfma16(A, Q[T][ks], acc[T][et]); }
                __builtin_amdgcn_sched_barrier(0); }
            { const float wiT = wint[16 * qt[T] + l15];
#pragma unroll
              for (int et = 0; et < 8; ++et) acc[T][et] = acc[T][et] * wiT; } }
        for (int kb = 0; kb < 4; ++kb) {
            wg_sync();
            { int tl = C.tid; asm volatile("" : "+v"(tl)); LAS unsigned char* kd = lds + KS + (tl >> 5) * KPITCH + (tl & 31) * 16; LAS unsigned char* vd = lds + VS + (tl >> 4) * VPITCH + (tl & 15) * 16;
#pragma unroll
              for (int i = 0; i < 4; ++i) *(LAS v4u*)(kd + i * 16 * KPITCH) = pk[i];
#pragma unroll
              for (int i = 0; i < 2; ++i) *(LAS v4u*)(vd + i * 32 * VPITCH) = pv[i]; }
            wg_sync();
            if (kb < 3) X3B_PREFETCH(kb + 1);
#pragma unroll
            for (int T = 0; T < 2; ++T) {
                if (4 * kb > qt[T]) continue;
                const int tq = 16 * qt[T] + l15; const float GtT = Gq[tq];
#pragma unroll
                for (int pp = 0; pp < 2; ++pp) { const int kta = 4 * kb + 2 * pp; if (kta > qt[T]) continue;
                    f32x4 Sa = {0.f, 0.f, 0.f, 0.f}, Sb = {0.f, 0.f, 0.f, 0.f}; const bool hasb = kta + 1 <= qt[T];
#pragma unroll
                    for (int ks = 0; ks < 8; ++ks) { const bf16x8 A = *(const LAS bf16x8*)(lds + KS + (32 * pp + l15) * KPITCH + (32 * ks + 8 * g) * 2); Sa = mfma16(A, Q[T][ks], Sa); }
                    if (hasb) {
#pragma unroll
                        for (int ks = 0; ks < 8; ++ks) { const bf16x8 A = *(const LAS bf16x8*)(lds + KS + (32 * pp + 16 + l15) * KPITCH + (32 * ks + 8 * g) * 2); Sb = mfma16(A, Q[T][ks], Sb); } }
#pragma unroll
                    for (int i = 0; i < 4; ++i) { const int sa_ = 16 * kta + 4 * g + i, sb_ = sa_ + 16;
                        const float wa = (sa_ <= tq) ? fexp(esb[sa_] - GtT) : 0.f, wb = (hasb && sb_ <= tq) ? fexp(esb[sb_] - GtT) : 0.f;
                        Sa[i] *= wa; Sb[i] *= wb; dsum[T] += Sa[i] + Sb[i]; }
                    v4u pw; pw.x = pk2(Sa[0], Sa[1]); pw.y = pk2(Sa[2], Sa[3]); pw.z = pk2(Sb[0], Sb[1]); pw.w = pk2(Sb[2], Sb[3]);
                    const bf16x8 Pf = __builtin_bit_cast(bf16x8, pw); const int r0 = 32 * pp + 4 * g;
#pragma unroll
                    for (int et = 0; et < 8; ++et) { const bf16x8 A = tr_frag(lds + VS, VPITCH, r0, r0 + 16, (16 * et + 4 * p) * 2, q); acc[T][et] = mfma16(A, Pf, acc[T][et]); }
                    __builtin_amdgcn_sched_barrier(0); }
            }
        }
#undef X3B_PREFETCH
#pragma unroll
        for (int T = 0; T < 2; ++T) { const int t = 16 * qt[T] + l15; const size_t m = (size_t)mbase + t;
            float ds = dsum[T]; ds += __shfl_xor(ds, 16); ds += __shfl_xor(ds, 32);
            const float den = (wint[t] * dqa[t] + ds) * 0.0625f, inv = 0.0625f / fmaxf(fabsf(den), mex[t]);
            v2u ogv[8];
#pragma unroll
            for (int et = 0; et < 8; ++et) ogv[et] = *(const v2u*)(PROJ + m * NIN + 5120 + 256 * hh + 128 * eh + 16 * et + 4 * g);
#pragma unroll
            for (int et = 0; et < 8; ++et) { const int e0 = 128 * eh + 16 * et + 4 * g; const v2u og = ogv[et];
                const float y0 = acc[T][et][0] * inv * sigmoid_f(bflo(og.x)), y1 = acc[T][et][1] * inv * sigmoid_f(bfhi(og.x)), y2 = acc[T][et][2] * inv * sigmoid_f(bflo(og.y)), y3 = acc[T][et][3] * inv * sigmoid_f(bfhi(og.y));
                if (OUT8) *(unsigned*)((unsigned char*)YCAT + m * D + 1024 + 256 * hh + e0) = pg8::cvt4_fp8(y0, y1, y2, y3);
                else { v2u o; o.x = pk2(y0, y1); o.y = pk2(y2, y3); *(v2u*)(YCAT + m * D + 1024 + 256 * hh + e0) = o; } } }
        wg_sync();
    }
}

#define GEMM_PHASE(EpiT, Eobj, Aptr, Bptr, NN, KK) do { pg8::Gemm g_{(const pg8::bf16_t*)(Aptr), (const pg8::bf16_t*)(Bptr), M, (NN), (KK)}; pg8::StaticOrder S_; S_.init(M, (NN), C0.G, C0.bid); \
    pg8::gemm_phase<EpiT, pg8::StaticOrder, true, true>(C0.lds, g_, S_, Eobj); } while (0)
#define GEMM_PHASEI8(EpiT, Eobj, Aptr, Bptr, NN, KBYTES) do { pg8::Gemm g_{(const pg8::bf16_t*)(Aptr), (const pg8::bf16_t*)(Bptr), M, (NN), (KBYTES) / 2}; pg8::StaticOrder S_; S_.init(M, (NN), C0.G, C0.bid); \
    pg8::gemm_phase<EpiT, pg8::StaticOrder, true, true, false, true>(C0.lds, g_, S_, Eobj); } while (0)
#define GEMM_PHASE8(EpiT, Eobj, Aptr, Bptr, NN, KBYTES) do { pg8::Gemm g_{(const pg8::bf16_t*)(Aptr), (const pg8::bf16_t*)(Bptr), M, (NN), (KBYTES) / 2}; pg8::StaticOrder S_; S_.init(M, (NN), C0.G, C0.bid); \
    pg8::gemm_phase<EpiT, pg8::StaticOrder, true, true, true>(C0.lds, g_, S_, Eobj); } while (0)
__global__ void __launch_bounds__(NT, 2) fwd(Args a) {
    extern __shared__ __attribute__((aligned(16))) unsigned char lds_raw[];
    Ctx C0; C0.lds = (LAS unsigned char*)lds_raw; C0.tid = threadIdx.x; C0.lane = C0.tid & 63; C0.wave = __builtin_amdgcn_readfirstlane(C0.tid >> 6); C0.G = gridDim.x; C0.bid = blockIdx.x;
    C0.gw = C0.bid * NWAVES + C0.wave; C0.ngw = C0.G * NWAVES;
#define PH(...) do { const Ctx C = fresh(C0); __VA_ARGS__; } while (0)
    volatile LAS unsigned* MISC = (volatile LAS unsigned*)(C0.lds + MISC_OFF);
    if (C0.tid < 128) MISC[C0.tid] = 0u;
    __syncthreads();
    unsigned char* ws = a.ws; unsigned* ctl = (unsigned*)(ws + WS_CTL);
    XcdBarrier bar = xcd_barrier_post(ctl + CW_BAR, MISC + 8);
    float* MOD = (float*)(ws + WS_SMALL + SM_MOD); bf16* XN = (bf16*)(ws + WS_XN); bf16* PROJ = (bf16*)(ws + WS_PROJ); bf16* ACT = (bf16*)(ws + WS_PROJ); bf16* YCAT = (bf16*)(ws + WS_YCAT);
    float* GATES = (float*)(ws + WS_SMALL + SM_GATES); float* SUMM = (float*)(ws + WS_SMALL + SM_SUMM); float* CH = (float*)(ws + WS_SMALL + SM_CH); float* CHS = (float*)(ws + WS_SMALL + SM_CHS); float* NST = (float*)(ws + WS_SMALL + SM_NST);
    bf16* HLOC = (bf16*)(ws + WS_XN); bf16* PCUM = (bf16*)(ws + WS_S1); bf16* USTATE = (bf16*)(ws + WS_S2);
    const bf16* waT = (const bf16*)(ws + WS_SMALL + SM_WAT); const bf16* wxT = (const bf16*)(ws + WS_SMALL + SM_WXT);
    bf16* X = (bf16*)(ws + WS_XB); float* SA = (float*)(ws + WS_SMALL + SM_SA);

    PH(p0_prologue(a, C)); xcd_barrier(bar);
    { const float* mod = MOD; unsigned char* wl = ws + WS_W;
#if INPROJ0_I8 == 2
      PH(norm_phase<false, 3, false>(a.in[0], a.in[4], mod + 0 * D, mod + 1 * D, XN, nullptr, nullptr, nullptr, SA + 2 * M, C, (unsigned char*)YCAT)); xcd_barrier(bar);
      { typedef pg8::EpiBf16P<true> EpiIn8; EpiIn8 E{(pg8::bf16_t*)PROJ, NIN, (float*)(ws + WS_CTL + CTL_KACC), SA + 2 * M, 1.0f / WIN_QW}; GEMM_PHASEI8(EpiIn8, E, YCAT, wl + LW_IN, 3072, D); }
      { typedef pg8::EpiBf16P<false> EpiIn; EpiIn E{(pg8::bf16_t*)PROJ + 3072, NIN, nullptr, nullptr, 1.0f}; GEMM_PHASE(EpiIn, E, XN, (bf16*)(wl + LW_IN) + (size_t)3072 * D, 3072, D); } xcd_barrier(bar);
#elif INPROJ0_I8
      PH(norm_phase<false, 2, false>(a.in[0], a.in[4], mod + 0 * D, mod + 1 * D, XN, nullptr, nullptr, nullptr, SA + 2 * M, C)); xcd_barrier(bar);
      { typedef pg8::EpiBf16P<true> EpiIn; EpiIn E{(pg8::bf16_t*)PROJ, NIN, (float*)(ws + WS_CTL + CTL_KACC), SA + 2 * M, 1.0f / WIN_QW}; GEMM_PHASEI8(EpiIn, E, XN, wl + LW_IN, NIN, D); } xcd_barrier(bar);
#else
      PH(norm_phase<false, 0, false>(a.in[0], a.in[4], mod + 0 * D, mod + 1 * D, XN, nullptr, nullptr, nullptr, nullptr, C)); xcd_barrier(bar);
      { typedef pg8::EpiBf16P<false> EpiIn; EpiIn E{(pg8::bf16_t*)PROJ, NIN, (float*)(ws + WS_CTL + CTL_KACC), nullptr, 1.0f}; GEMM_PHASE(EpiIn, E, XN, wl + LW_IN, NIN, D); } xcd_barrier(bar);
#endif
      PH(conv_phase(PROJ, a.in[10], YCAT, C));
      { unsigned* MCNT = (unsigned*)(ws + WS_CTL + CTL_MCNT); unsigned* MLIST = (unsigned*)(ws + WS_XN + 8 * MiB); float* MML = (float*)(ws + WS_XN); bf16* MPART = (bf16*)(ws + WS_S1);
        PH(for (int u = C.bid; u < 512; u += C.G) { const int kk = (u >> 4) & 15; const int j = (u < 256) ? 31 - kk : kk; const int bh = u & 15; moba_gate_unit(PROJ, (const float*)(ws + WS_CTL + CTL_KACC), MCNT, MLIST, bh >> 3, bh & 7, j, C); });
        xcd_barrier(bar);
        PH(moba_work_phase(PROJ, MCNT, MLIST, (unsigned*)(ws + WS_CTL + CTL_MQ), MPART, MML, C));
        xcd_barrier(bar);
        PH(moba_merge_phase(MPART, MML, YCAT, C)); }
      xcd_barrier(bar);
      { typedef pg8::EpiResGate<true> EpiR0; EpiR0 E{a.in[0], (pg8::bf16_t*)X, D, mod + 2 * D, MODW, 1.0f}; GEMM_PHASE(EpiR0, E, YCAT, wl + LW_OUT, D, D); } xcd_barrier(bar);
      PH(norm_phase<false, 2, true>(X, a.in[5], mod + 3 * D, mod + 4 * D, XN, nullptr, nullptr, nullptr, SA, C)); xcd_barrier(bar);
#if FFN0_DOWN_FP8
      { typedef pg8::EpiSwiGLU<true, true> EpiUp; EpiUp E{(void*)ACT, FF, 1.0f / W13_QW, SA}; GEMM_PHASEI8(EpiUp, E, XN, wl + LW_13, N13, D); } xcd_barrier(bar);
      { typedef pg8::EpiResGate<false> EpiR; EpiR E{X, (pg8::bf16_t*)X, D, mod + 5 * D, MODW, 1.0f / W2_SCALE}; GEMM_PHASE8(EpiR, E, ACT, wl + LW_2, D, FF); } xcd_barrier(bar);
#else
      { typedef pg8::EpiSwiGLU<false, true> EpiUp; EpiUp E{(void*)ACT, FF, 1.0f / W13_QW, SA}; GEMM_PHASEI8(EpiUp, E, XN, wl + LW_13, N13, D); } xcd_barrier(bar);
      { typedef pg8::EpiResGate<false> EpiR; EpiR E{X, (pg8::bf16_t*)X, D, mod + 5 * D, MODW, 1.0f}; GEMM_PHASE(EpiR, E, ACT, wl + LW_2, D, FF); } xcd_barrier(bar);
#endif
    }
    { const float* mod = MOD + 2 * MODW; unsigned char* wl = ws + WS_W + LW_SIZE;
#if INPROJ1_I8
      PH(norm_phase<true, 3, true>(X, a.in[4] + D, mod + 0 * D, mod + 1 * D, XN, a.in[12], a.in[13], GATES, SA + 3 * M, C, (unsigned char*)YCAT)); xcd_barrier(bar);
      { typedef pg8::EpiBf16P<true> EpiIn8; EpiIn8 E{(pg8::bf16_t*)PROJ, NIN, nullptr, SA + 3 * M, 1.0f / WIN_QW, 8, 8}; GEMM_PHASEI8(EpiIn8, E, YCAT, wl + LW_IN, 4096, D); }
      { typedef pg8::EpiBf16P<false> EpiIn; EpiIn E{(pg8::bf16_t*)PROJ + 2048, NIN, nullptr, nullptr, 1.0f}; GEMM_PHASE(EpiIn, E, XN, (bf16*)(wl + LW_IN) + (size_t)2048 * D, 2048, D); } xcd_barrier(bar);
#else
      PH(norm_phase<true, 0, true>(X, a.in[4] + D, mod + 0 * D, mod + 1 * D, XN, a.in[12], a.in[13], GATES, nullptr, C)); xcd_barrier(bar);
      { typedef pg8::EpiBf16P<false> EpiIn; EpiIn E{(pg8::bf16_t*)PROJ, NIN, nullptr, nullptr, 1.0f}; GEMM_PHASE(EpiIn, E, XN, wl + LW_IN, NIN, D); } xcd_barrier(bar);
#endif
      PH(for (int u = C.bid; u < 256; u += C.G) { rg_step1_unit(PROJ, waT, wxT, a.in[14], a.in[15], a.in[17], a.in[19], a.in[20], HLOC, PCUM, SUMM, u >> 7, (u >> 4) & 7, u & 15, C); wg_sync(); });
      PH(for (int u = C.bid; u < 256; u += C.G) { mlstm_x1_unit(PROJ, GATES, USTATE, NST, CH, u >> 7, (u >> 5) & 3, u & 31, C); wg_sync(); });
      xcd_barrier(bar);
      PH(mlstm_x2(USTATE, NST, CH, CHS, C)); xcd_barrier(bar);
      PH(for (int u = C.bid; u < 256; u += C.G) rg_step2_unit<OUT1_FP8>(PROJ, HLOC, PCUM, SUMM, YCAT, u >> 7, (u >> 4) & 7, u & 15, C));
      PH(for (int u = C.bid; u < 256; u += C.G) mlstm_x3b_unit<OUT1_FP8>(PROJ, GATES, USTATE, NST, CHS, YCAT, u >> 7, (u >> 5) & 3, u & 31, C));
      xcd_barrier(bar);
#if OUT1_FP8
      { typedef pg8::EpiResGate<false> EpiR; EpiR E{X, (pg8::bf16_t*)X, D, mod + 2 * D, MODW, 1.0f / WOUT_SCALE}; GEMM_PHASE8(EpiR, E, YCAT, wl + LW_OUT, D, D); } xcd_barrier(bar);
#else
      { typedef pg8::EpiResGate<false> EpiR; EpiR E{X, (pg8::bf16_t*)X, D, mod + 2 * D, MODW, 1.0f}; GEMM_PHASE(EpiR, E, YCAT, wl + LW_OUT, D, D); } xcd_barrier(bar);
#endif
#if UP1_FP8
      PH(norm_phase<false, 1, true>(X, a.in[5] + D, mod + 3 * D, mod + 4 * D, XN, nullptr, nullptr, nullptr, nullptr, C)); xcd_barrier(bar);
      { typedef pg8::EpiSwiGLU<true, false> EpiUp8; EpiUp8 E{(void*)ACT, FF, 1.0f / 64.0f, nullptr}; GEMM_PHASE8(EpiUp8, E, XN, wl + LW_13, N13, D); } xcd_barrier(bar);
#else
      PH(norm_phase<false, 2, true>(X, a.in[5] + D, mod + 3 * D, mod + 4 * D, XN, nullptr, nullptr, nullptr, SA + M, C)); xcd_barrier(bar);
      { typedef pg8::EpiSwiGLU<true, true> EpiUp; EpiUp E{(void*)ACT, FF, 1.0f / W13_QW, SA + M}; GEMM_PHASEI8(EpiUp, E, XN, wl + LW_13, N13, D); } xcd_barrier(bar);
#endif
      { typedef pg8::EpiResGate<false> EpiR; EpiR E{X, (pg8::bf16_t*)X, D, mod + 5 * D, MODW, 1.0f / W2_SCALE}; GEMM_PHASE8(EpiR, E, ACT, wl + LW_2, D, FF); } xcd_barrier(bar);
    }
    PH(final_norm(X, a.out, a.in[22], C));
}

extern "C" void kernel_launch(void* const* d_in, const int* in_sizes, int n_in, void* d_out, int out_size, void* d_ws, size_t ws_size, hipStream_t stream) {
    static int grid = 0;
    if (grid == 0) {
        if (n_in != 23 || out_size != M * D || ws_size < WS_END) { fprintf(stderr, "kernel_launch: unexpected shapes (n_in %d out %d ws %zu)\n", n_in, out_size, ws_size); grid = -1; return; }
        int dev = 0, cus = 0, per_cu = 0;
        if (hipGetDevice(&dev) != hipSuccess || hipDeviceGetAttribute(&cus, hipDeviceAttributeMultiprocessorCount, dev) != hipSuccess) { grid = -1; return; }
        if (hipFuncSetAttribute((const void*)fwd, hipFuncAttributeMaxDynamicSharedMemorySize, LDS_BYTES) != hipSuccess) { fprintf(stderr, "kernel_launch: hipFuncSetAttribute failed\n"); grid = -1; return; }
        if (hipOccupancyMaxActiveBlocksPerMultiprocessor(&per_cu, (const void*)fwd, NT, LDS_BYTES) != hipSuccess || per_cu < 1) { fprintf(stderr, "kernel_launch: occupancy query says %d\n", per_cu); (void)hipGetLastError(); grid = -1; return; }
        grid = cus;
    }
    if (grid < 0) return;
    if (hipMemsetAsync((char*)d_ws + WS_CTL, 0, CTL_ZERO_BYTES, stream) != hipSuccess) return;
    Args a{};
    for (int i = 0; i < 23; ++i) a.in[i] = (const float*)d_in[i];
    a.out = (float*)d_out; a.ws = (unsigned char*)d_ws;
    hipLaunchKernelGGL(fwd, dim3(grid), dim3(NT), LDS_BYTES, stream, a);
}
```

```cpp
#include <hip/hip_runtime.h>
#include <cstdio>
#include <cstdint>
namespace pg8 {
#define PG8_LAS __attribute__((address_space(3)))
typedef unsigned short bf16_t;
typedef short bf16x8 __attribute__((ext_vector_type(8)));
typedef float f32x4 __attribute__((ext_vector_type(4)));
typedef unsigned u32x4 __attribute__((ext_vector_type(4)));
constexpr int BM = 256, BK = 64, HALF = 128, HTB = HALF * BK * 2  , STAGE_BYTES = 8 * HTB, NXCD = 8, WGM = 8;

__host__ __device__ __forceinline__ int lds_byte(int r, int c) { const int st = (r >> 4) * 2 + (c >> 5), rr = r & 15, cc = c & 31, ob = rr * 64 + cc * 2; return st * 1024 + (ob ^ (((ob >> 9) & 1) << 5)); }
__host__ __device__ __forceinline__ void stage_rc(int b, int& R, int& C) { const int st = b / 1024, sb = b % 1024, swz = sb ^ (((sb >> 9) & 1) << 5); R = (st >> 1) * 16 + swz / 64; C = (st & 1) * 32 + (swz % 64) / 2; }
__host__ __device__ __forceinline__ int perm32(int rho) { const int n = rho >> 4, i = rho & 15; return 8 * (i >> 2) + 4 * n + (i & 3); }

struct Unit { int pm, pn; };
struct Gemm { const bf16_t* A; const bf16_t* Bt; int M, N, K; };

struct StaticOrder {
    int nM, nN, nwg, G, c;
    __host__ __device__ void init(int M, int N, int G_, int c_) { nM = M / BM; nN = N / BM; nwg = nM * nN; G = G_; c = c_; }
    __host__ __device__ bool next(int i, Unit& u) const {
        const long L = (long)i * G + c; if (L >= nwg) return false;
        int wgid = (int)L; { const int q = nwg / NXCD, r = nwg % NXCD, xcd = wgid % NXCD, off = wgid / NXCD; wgid = (xcd < r ? xcd * (q + 1) : r * (q + 1) + (xcd - r) * q) + off; }
        const int nig = WGM * nN, gid = wgid / nig, fm = gid * WGM, gsz = (nM - fm) < WGM ? (nM - fm) : WGM;
        u.pm = fm + ((wgid % nig) % gsz); u.pn = (wgid % nig) / gsz; return true;
    }
    __device__ __forceinline__ void a_ready(const Unit&) const {}
    __device__ __forceinline__ void done(const Unit&) const {}
};
__device__ __forceinline__ unsigned cvt_pk_bf16(float lo, float hi) { unsigned r; asm volatile("v_cvt_pk_bf16_f32 %0, %1, %2" : "=v"(r) : "v"(lo), "v"(hi)); return r; }
typedef float f32x2 __attribute__((ext_vector_type(2)));
__device__ __forceinline__ f32x4 cvt_i32x4(f32x4 v) { const float f0 = v[0], f1 = v[1], f2 = v[2], f3 = v[3];
    f32x4 r = {(float)__float_as_int(f0), (float)__float_as_int(f1), (float)__float_as_int(f2), (float)__float_as_int(f3)}; return r; }
template <bool IN_I8> struct EpiBf16P {
    static constexpr bool PERM = true, AFTER_DRAIN = false, PRE = false;
    bf16_t* O; int ldc; float* kacc; const float* sa; float inscale; int pn_split = 1 << 30, pn_skip = 0;
    __device__ __forceinline__ void operator()(const f32x4 (&acc)[2][2][4][2], const Unit& u, int wr, int wc, int fr, int fq) const {
        const unsigned loff = (unsigned)((wr * 64 + fr) * ldc + wc * 32 + 8 * fq);
        bf16_t* tile = O + ((size_t)u.pm * BM * ldc + (size_t)(u.pn + (u.pn >= pn_split ? pn_skip : 0)) * BM);
        const bool ksum = kacc != nullptr && (u.pn >> 2) == 1;
        f32x4 ks[2][2];
#pragma unroll
        for (int bj = 0; bj < 2; ++bj)
#pragma unroll
            for (int n = 0; n < 2; ++n) ks[bj][n] = (f32x4){0.f, 0.f, 0.f, 0.f};
#pragma unroll
        for (int ai = 0; ai < 2; ++ai)
#pragma unroll
            for (int m = 0; m < 4; ++m) { bf16_t* rowp = tile + (size_t)(ai * HALF + m * 16) * ldc + loff;
                float rs = 1.0f; if constexpr (IN_I8) rs = sa[u.pm * BM + wr * 64 + fr + ai * HALF + m * 16] * inscale;
#pragma unroll
                for (int bj = 0; bj < 2; ++bj) { f32x4 v0 = acc[ai][bj][m][0], v1 = acc[ai][bj][m][1];
                    if constexpr (IN_I8) { v0 = cvt_i32x4(v0) * rs; v1 = cvt_i32x4(v1) * rs; }
                    ks[bj][0] += v0; ks[bj][1] += v1;
                    u32x4 w; w.x = cvt_pk_bf16(v0[0], v0[1]); w.y = cvt_pk_bf16(v0[2], v0[3]); w.z = cvt_pk_bf16(v1[0], v1[1]); w.w = cvt_pk_bf16(v1[2], v1[3]);
                    *(u32x4*)(rowp + bj * HALF) = w; } }
        if (ksum) {
            float* kp = kacc + (size_t)u.pm * 1024 + (u.pn - 4) * BM + wc * 32 + 8 * fq;
#pragma unroll
            for (int bj = 0; bj < 2; ++bj)
#pragma unroll
                for (int n = 0; n < 2; ++n) { f32x4 s = ks[bj][n];
#pragma unroll
                    for (int o = 1; o < 16; o <<= 1) { s[0] += __shfl_xor(s[0], o); s[1] += __shfl_xor(s[1], o); s[2] += __shfl_xor(s[2], o); s[3] += __shfl_xor(s[3], o); }
                    if (fr == 0) {
#pragma unroll
                        for (int i = 0; i < 4; ++i) __hip_atomic_fetch_add(kp + bj * HALF + 4 * n + i, s[i], __ATOMIC_RELAXED, __HIP_MEMORY_SCOPE_AGENT); } }
        }
    }
};
__device__ __forceinline__ float silu_f(float a) { return a * __builtin_amdgcn_rcpf(1.0f + __builtin_amdgcn_exp2f(-1.4426950409f * a)); }
__device__ __forceinline__ unsigned cvt4_fp8(float a, float b, float c, float d) {
    a = fminf(fmaxf(a, -448.f), 448.f); b = fminf(fmaxf(b, -448.f), 448.f); c = fminf(fmaxf(c, -448.f), 448.f); d = fminf(fmaxf(d, -448.f), 448.f);
    int w = __builtin_amdgcn_cvt_pk_fp8_f32(a, b, 0, false); w = __builtin_amdgcn_cvt_pk_fp8_f32(c, d, w, true); return (unsigned)w; }

template <bool OUT8, bool IN_I8> struct EpiSwiGLU {
    static constexpr bool PERM = true, AFTER_DRAIN = false, PRE = IN_I8;
    void* O; int ldc; float inscale; const float* sa;
    __device__ __forceinline__ void pre(const Unit& u, int wr, int fr, float (&sr)[8]) const {
#pragma unroll
        for (int i = 0; i < 8; ++i) sr[i] = sa[u.pm * BM + wr * 64 + fr + (i >> 2) * HALF + (i & 3) * 16]; }
    __device__ __forceinline__ void operator()(const f32x4 (&acc)[2][2][4][2], const Unit& u, int wr, int wc, int fr, int fq) const { float one[8] = {1.f, 1.f, 1.f, 1.f, 1.f, 1.f, 1.f, 1.f}; (*this)(acc, u, wr, wc, fr, fq, one); }
    __device__ __forceinline__ void operator()(const f32x4 (&acc)[2][2][4][2], const Unit& u, int wr, int wc, int fr, int fq, const float (&srow)[8]) const {
        const unsigned loff = (unsigned)((wr * 64 + fr) * ldc + wc * 32 + 8 * fq); const size_t toff = (size_t)u.pm * BM * ldc + (size_t)u.pn * HALF;
#pragma unroll
        for (int ai = 0; ai < 2; ++ai)
#pragma unroll
            for (int m = 0; m < 4; ++m) { const size_t ro = toff + (size_t)(ai * HALF + m * 16) * ldc;
                float s2 = inscale; if constexpr (IN_I8) s2 *= srow[ai * 4 + m];
                f32x4 a0 = acc[ai][0][m][0], a1 = acc[ai][0][m][1], b0 = acc[ai][1][m][0], b1 = acc[ai][1][m][1];
                if constexpr (IN_I8) { a0 = cvt_i32x4(a0); a1 = cvt_i32x4(a1); b0 = cvt_i32x4(b0); b1 = cvt_i32x4(b1); }
                const float k1 = -1.4426950409f * s2, k2 = s2 * s2;
                const f32x4 t0 = a0 * k1, t1 = a1 * k1; f32x4 d0, d1;
#pragma unroll
                for (int i = 0; i < 4; ++i) { d0[i] = __builtin_amdgcn_exp2f(t0[i]); d1[i] = __builtin_amdgcn_exp2f(t1[i]); }
                d0 = d0 + 1.0f; d1 = d1 + 1.0f;
#pragma unroll
                for (int i = 0; i < 4; ++i) { d0[i] = __builtin_amdgcn_rcpf(d0[i]); d1[i] = __builtin_amdgcn_rcpf(d1[i]); }
                const f32x4 o0 = (a0 * b0) * (d0 * k2), o1 = (a1 * b1) * (d1 * k2);
                const float r0 = o0[0], r1 = o0[1], r2 = o0[2], r3 = o0[3], r4 = o1[0], r5 = o1[1], r6 = o1[2], r7 = o1[3];
                if constexpr (OUT8) { typedef unsigned u32x2 __attribute__((ext_vector_type(2))); u32x2 w; w.x = cvt4_fp8(r0, r1, r2, r3); w.y = cvt4_fp8(r4, r5, r6, r7); *(u32x2*)((unsigned char*)O + ro + loff) = w; }
                else { u32x4 w; w.x = cvt_pk_bf16(r0, r1); w.y = cvt_pk_bf16(r2, r3); w.z = cvt_pk_bf16(r4, r5); w.w = cvt_pk_bf16(r6, r7); *(u32x4*)((bf16_t*)O + ro + loff) = w; } }
    }
};
template <bool BASE_F32> struct EpiResGate {
    static constexpr bool PERM = true, AFTER_DRAIN = false, PRE = false;
    const void* base; bf16_t* out; int ldc; const float* gate; int gstride; float ascale;
    __device__ __forceinline__ void operator()(const f32x4 (&acc)[2][2][4][2], const Unit& u, int wr, int wc, int fr, int fq) const {
        const unsigned loff = (unsigned)((wr * 64 + fr) * ldc + wc * 32 + 8 * fq); const size_t toff = (size_t)u.pm * BM * ldc + (size_t)u.pn * BM;
        const float* gp = gate + (size_t)(u.pm >> 5) * gstride + u.pn * BM + (wc * 32 + 8 * fq);
        f32x4 gv[2][2];
#pragma unroll
        for (int bj = 0; bj < 2; ++bj)
#pragma unroll
            for (int n = 0; n < 2; ++n) gv[bj][n] = *(const f32x4*)(gp + bj * HALF + 4 * n) * ascale;
#pragma unroll
        for (int ai = 0; ai < 2; ++ai) {
            if constexpr (BASE_F32) {
#pragma unroll
                for (int mh = 0; mh < 2; ++mh) { f32x4 bs[2][2][2];
#pragma unroll
                    for (int mm = 0; mm < 2; ++mm)
#pragma unroll
                        for (int bj = 0; bj < 2; ++bj)
#pragma unroll
                            for (int n = 0; n < 2; ++n) bs[mm][bj][n] = __builtin_nontemporal_load((const f32x4*)((const float*)base + toff + (size_t)(ai * HALF + (2 * mh + mm) * 16) * ldc + bj * HALF + 4 * n + loff));
#pragma unroll
                    for (int mm = 0; mm < 2; ++mm) { const int m = 2 * mh + mm; bf16_t* op = out + toff + (size_t)(ai * HALF + m * 16) * ldc;
#pragma unroll
                        for (int bj = 0; bj < 2; ++bj) { const f32x4 x0 = bs[mm][bj][0] + gv[bj][0] * acc[ai][bj][m][0], x1 = bs[mm][bj][1] + gv[bj][1] * acc[ai][bj][m][1];
                            u32x4 w; w.x = cvt_pk_bf16(x0[0], x0[1]); w.y = cvt_pk_bf16(x0[2], x0[3]); w.z = cvt_pk_bf16(x1[0], x1[1]); w.w = cvt_pk_bf16(x1[2], x1[3]); *(u32x4*)(op + bj * HALF + loff) = w; } }
                    asm volatile("" ::: "memory"); }
            } else { u32x4 rb[4][2];
#pragma unroll
                for (int m = 0; m < 4; ++m)
#pragma unroll
                    for (int bj = 0; bj < 2; ++bj) rb[m][bj] = *(const u32x4*)((const bf16_t*)base + toff + (size_t)(ai * HALF + m * 16) * ldc + bj * HALF + loff);
#pragma unroll
                for (int m = 0; m < 4; ++m) { bf16_t* op = out + toff + (size_t)(ai * HALF + m * 16) * ldc;
#pragma unroll
                    for (int bj = 0; bj < 2; ++bj) { const u32x4 r = rb[m][bj];
                        const f32x4 b0 = {__uint_as_float(r.x << 16), __uint_as_float(r.x & 0xffff0000u), __uint_as_float(r.y << 16), __uint_as_float(r.y & 0xffff0000u)}, b1 = {__uint_as_float(r.z << 16), __uint_as_float(r.z & 0xffff0000u), __uint_as_float(r.w << 16), __uint_as_float(r.w & 0xffff0000u)};
                        const f32x4 x0 = b0 + gv[bj][0] * acc[ai][bj][m][0], x1 = b1 + gv[bj][1] * acc[ai][bj][m][1];
                        u32x4 w; w.x = cvt_pk_bf16(x0[0], x0[1]); w.y = cvt_pk_bf16(x0[2], x0[3]); w.z = cvt_pk_bf16(x1[0], x1[1]); w.w = cvt_pk_bf16(x1[2], x1[3]); *(u32x4*)(op + bj * HALF + loff) = w; } }
                asm volatile("" ::: "memory"); }
        }
    }
};
typedef int pg8_v8i __attribute__((ext_vector_type(8))); typedef int pg8_v4i __attribute__((ext_vector_type(4)));
__device__ __forceinline__ pg8_v8i pg8_cat(bf16x8 a, bf16x8 b) { const pg8_v4i x = __builtin_bit_cast(pg8_v4i, a), y = __builtin_bit_cast(pg8_v4i, b); return __builtin_shufflevector(x, y, 0, 1, 2, 3, 4, 5, 6, 7); }
__device__ __forceinline__ void pg8_mfma8(f32x4& acc, pg8_v8i a, pg8_v8i b, int sc) {
    asm volatile("v_mfma_scale_f32_16x16x128_f8f6f4 %0, %1, %2, %0, %3, %3 op_sel_hi:[0,0,0]" : "+v"(acc) : "v"(a), "v"(b), "v"(sc)); }
template <class Epi, class Sched, bool ALIGN_EPI = false, bool SP2 = false, bool FP8 = false, bool I8 = false>
__device__ __forceinline__ void gemm_phase(PG8_LAS unsigned char* lds, const Gemm g, const Sched& S, const Epi& E) {
    int tid = threadIdx.x; asm volatile("" : "+v"(tid));
    const int wid = __builtin_amdgcn_readfirstlane(tid >> 6), lane = tid & 63, wr = wid >> 2, wc = wid & 3, fr = lane & 15, fq = lane >> 4;
    const int K = g.K, nt = K / BK;
    unsigned voffA[2], voffB[2];
#pragma unroll
    for (int i = 0; i < 2; ++i) { int R, C; stage_rc(tid * 16 + i * 8192, R, C); const int Rb = Epi::PERM ? ((R & ~31) + perm32(R & 31)) : R;
        voffA[i] = (unsigned)(R * K + C) * 2u; voffB[i] = (unsigned)(Rb * K + C) * 2u; }
    const size_t kstep = (size_t)(BK * 2);
    const size_t hstep = (size_t)HALF * K * 2;
    const size_t tstep = 2 * hstep;
    const unsigned ldsw = (unsigned)wid * 1024u;
    const int aoff = lds_byte(wr * 64 + fr, fq * 8), boff = lds_byte(wc * 32 + fr, fq * 8);
#define PG8_SA(b, h) (((b) * 2 + (h)) * HTB)
#define PG8_SB(b, h) ((4 + (b) * 2 + (h)) * HTB)
#define PG8_STAGE(bufoff, gbase, voff) do { _Pragma("unroll") for (int _i = 0; _i < 2; ++_i) \
        __builtin_amdgcn_global_load_lds((const unsigned*)((const char*)(gbase) + (voff)[_i]), (PG8_LAS unsigned*)(lds + (bufoff) + ldsw + _i * 8192), 16, 0, 0); } while (0)
#define PG8_LDA(dst, b, h) do { _Pragma("unroll") for (int m = 0; m < 4; ++m) _Pragma("unroll") for (int k = 0; k < 2; ++k) dst[m][k] = *(const PG8_LAS bf16x8*)(lds + PG8_SA(b, h) + aoff + m * 2048 + k * 1024); } while (0)
#define PG8_LDB(dst, b, h) do { _Pragma("unroll") for (int n = 0; n < 2; ++n) _Pragma("unroll") for (int k = 0; k < 2; ++k) dst[n][k] = *(const PG8_LAS bf16x8*)(lds + PG8_SB(b, h) + boff + n * 2048 + k * 1024); } while (0)
#define PG8_MMA(ai, bj, At, Bt) do { __builtin_amdgcn_s_setprio(1); \
        if constexpr (FP8) { _Pragma("unroll") for (int m = 0; m < 4; ++m) _Pragma("unroll") for (int n = 0; n < 2; ++n) \
            pg8_mfma8(acc[ai][bj][m][n], pg8_cat(Bt[n][0], Bt[n][1]), pg8_cat(At[m][0], At[m][1]), unit_scale); } \
        else if constexpr (I8) { _Pragma("unroll") for (int m = 0; m < 4; ++m) _Pragma("unroll") for (int n = 0; n < 2; ++n) _Pragma("unroll") for (int k = 0; k < 2; ++k) \
            acc[ai][bj][m][n] = __builtin_bit_cast(f32x4, __builtin_amdgcn_mfma_i32_16x16x64_i8(__builtin_bit_cast(pg8_v4i, Bt[n][k]), __builtin_bit_cast(pg8_v4i, At[m][k]), __builtin_bit_cast(pg8_v4i, acc[ai][bj][m][n]), 0, 0, 0)); } \
        else { _Pragma("unroll") for (int m = 0; m < 4; ++m) _Pragma("unroll") for (int n = 0; n < 2; ++n) _Pragma("unroll") for (int k = 0; k < 2; ++k) \
            acc[ai][bj][m][n] = __builtin_amdgcn_mfma_f32_16x16x32_bf16(Bt[n][k], At[m][k], acc[ai][bj][m][n], 0, 0, 0); } \
        __builtin_amdgcn_s_setprio(0); } while (0)
#define PG8_WAIT_V(n) asm volatile("s_waitcnt vmcnt(" #n ")" ::: "memory")
#define PG8_WAIT_L(n) asm volatile("s_waitcnt lgkmcnt(" #n ")" ::: "memory")
#define PG8_BAR __builtin_amdgcn_s_barrier()
#define PG8_SCHED __builtin_amdgcn_sched_barrier(0)
    Unit cur, nxt; int ui = 0;
    if (!S.next(0, cur)) return;
    f32x4 acc[2][2][4][2];
#pragma unroll
    for (int a = 0; a < 2; ++a)
#pragma unroll
        for (int b = 0; b < 2; ++b)
#pragma unroll
            for (int m = 0; m < 4; ++m)
#pragma unroll
                for (int n = 0; n < 2; ++n) acc[a][b][m][n] = (f32x4){0.f, 0.f, 0.f, 0.f};
    bf16x8 At[4][2], B0[2][2], B1[2][2]; int unit_scale = 0x7F7F7F7F; asm volatile("" : "+v"(unit_scale));
    const char* cA = (const char*)g.A + (size_t)cur.pm * tstep; const char* cB = (const char*)g.Bt + (size_t)cur.pn * tstep;
    float epre[8];
    if constexpr (Epi::PRE) E.pre(cur, wr, fr, epre);
    S.a_ready(cur);
    if constexpr (SP2) {
        PG8_STAGE(PG8_SB(0, 0), cB, voffB); PG8_STAGE(PG8_SB(0, 1), cB + hstep, voffB); PG8_STAGE(PG8_SA(0, 0), cA, voffA); PG8_STAGE(PG8_SA(0, 1), cA + hstep, voffA);
        if (wr == 1) PG8_BAR;
        PG8_WAIT_V(2); PG8_BAR;
        PG8_STAGE(PG8_SB(1, 0), cB + kstep, voffB); PG8_STAGE(PG8_SA(1, 0), cA + kstep, voffA); PG8_STAGE(PG8_SB(1, 1), cB + hstep + kstep, voffB);
        PG8_WAIT_V(6); PG8_BAR;
    } else {
        PG8_STAGE(PG8_SB(0, 0), cB, voffB); PG8_STAGE(PG8_SA(0, 0), cA, voffA); PG8_STAGE(PG8_SB(0, 1), cB + hstep, voffB); PG8_STAGE(PG8_SA(0, 1), cA + hstep, voffA);
        if (wr == 1) PG8_BAR;
        PG8_WAIT_V(4); PG8_BAR;
        PG8_STAGE(PG8_SB(1, 0), cB + kstep, voffB); PG8_STAGE(PG8_SA(1, 0), cA + kstep, voffA); PG8_STAGE(PG8_SB(1, 1), cB + hstep + kstep, voffB);
        PG8_WAIT_V(6); PG8_BAR;
    }
    for (;;) {
        const bool has_next = S.next(ui + 1, nxt);
        const char* nA = has_next ? (const char*)g.A + (size_t)nxt.pm * tstep : cA; const char* nB = has_next ? (const char*)g.Bt + (size_t)nxt.pn * tstep : cB;
        for (int t = 0; t < nt; t += 2) {
            const bool last = (t == nt - 2);
            const char* a1 = cA + (size_t)(t + 1) * kstep;
            const char* a2 = last ? nA : cA + (size_t)(t + 2) * kstep; const char* b2 = last ? nB : cB + (size_t)(t + 2) * kstep;
            const char* a3 = a2 + kstep; const char* b3 = b2 + kstep;
            if (last && has_next) S.a_ready(nxt);
            if constexpr (SP2) {
            PG8_LDB(B0, 0, 0); PG8_LDB(B1, 0, 1); PG8_SCHED; PG8_LDA(At, 0, 0); PG8_STAGE(PG8_SA(1, 1), a1 + hstep, voffA);
            PG8_WAIT_V(8); PG8_WAIT_L(0); PG8_BAR; PG8_MMA(0, 0, At, B0); PG8_MMA(0, 1, At, B1); PG8_BAR; PG8_SCHED;
            PG8_LDA(At, 0, 1); PG8_STAGE(PG8_SB(0, 0), b2, voffB); PG8_STAGE(PG8_SB(0, 1), b2 + hstep, voffB); PG8_STAGE(PG8_SA(0, 0), a2, voffA);
            PG8_WAIT_V(8); PG8_WAIT_L(0); PG8_BAR; PG8_MMA(1, 0, At, B0); PG8_MMA(1, 1, At, B1); PG8_BAR; PG8_SCHED;
            PG8_LDB(B0, 1, 0); PG8_LDB(B1, 1, 1); PG8_SCHED; PG8_LDA(At, 1, 0); PG8_STAGE(PG8_SA(0, 1), a2 + hstep, voffA);
            PG8_WAIT_V(8); PG8_WAIT_L(0); PG8_BAR; PG8_MMA(0, 0, At, B0); PG8_MMA(0, 1, At, B1); PG8_BAR; PG8_SCHED;
            PG8_LDA(At, 1, 1); PG8_STAGE(PG8_SB(1, 0), b3, voffB); PG8_STAGE(PG8_SB(1, 1), b3 + hstep, voffB); PG8_STAGE(PG8_SA(1, 0), a3, voffA);
            PG8_WAIT_V(8); PG8_WAIT_L(0); PG8_BAR; PG8_MMA(1, 0, At, B0); PG8_MMA(1, 1, At, B1); PG8_BAR; PG8_SCHED;
            } else {
            PG8_LDB(B0, 0, 0); PG8_SCHED; PG8_LDA(At, 0, 0); PG8_STAGE(PG8_SA(1, 1), a1 + hstep, voffA);
            PG8_WAIT_L(8); PG8_BAR; PG8_WAIT_L(0); PG8_MMA(0, 0, At, B0); PG8_BAR; PG8_SCHED;
            PG8_LDB(B1, 0, 1); PG8_STAGE(PG8_SB(0, 0), b2, voffB);
            PG8_BAR; PG8_WAIT_L(0); PG8_MMA(0, 1, At, B1); PG8_BAR;
            PG8_LDA(At, 0, 1); PG8_STAGE(PG8_SA(0, 0), a2, voffA);
            PG8_BAR; PG8_WAIT_L(0); PG8_MMA(1, 0, At, B0); PG8_BAR; PG8_SCHED;
            PG8_STAGE(PG8_SB(0, 1), b2 + hstep, voffB);
            PG8_WAIT_V(6); PG8_BAR; PG8_MMA(1, 1, At, B1); PG8_BAR;
            PG8_LDB(B0, 1, 0); PG8_SCHED; PG8_LDA(At, 1, 0); PG8_STAGE(PG8_SA(0, 1), a2 + hstep, voffA);
            PG8_WAIT_L(8); PG8_BAR; PG8_WAIT_L(0); PG8_MMA(0, 0, At, B0); PG8_BAR; PG8_SCHED;
            PG8_LDB(B1, 1, 1); PG8_STAGE(PG8_SB(1, 0), b3, voffB);
            PG8_BAR; PG8_WAIT_L(0); PG8_MMA(0, 1, At, B1); PG8_BAR;
            PG8_LDA(At, 1, 1); PG8_STAGE(PG8_SA(1, 0), a3, voffA);
            PG8_BAR; PG8_WAIT_L(0); PG8_MMA(1, 0, At, B0); PG8_BAR; PG8_SCHED;
            PG8_STAGE(PG8_SB(1, 1), b3 + hstep, voffB);
            PG8_WAIT_V(6); PG8_BAR; PG8_MMA(1, 1, At, B1); PG8_BAR;
            }
        }
        if constexpr (ALIGN_EPI) { if (wr == 0) PG8_BAR; }
        if constexpr (FP8) asm volatile("s_nop 15\n\ts_nop 15\n\ts_nop 15" ::: "memory");
        if constexpr (!Epi::AFTER_DRAIN) { if constexpr (Epi::PRE) E(acc, cur, wr, wc, fr, fq, epre); else E(acc, cur, wr, wc, fr, fq); S.done(cur); }
        if (!has_next) break;
#pragma unroll
        for (int a = 0; a < 2; ++a)
#pragma unroll
            for (int b = 0; b < 2; ++b)
#pragma unroll
                for (int m = 0; m < 4; ++m)
#pragma unroll
                    for (int n = 0; n < 2; ++n) acc[a][b][m][n] = (f32x4){0.f, 0.f, 0.f, 0.f};
        cur = nxt; cA = nA; cB = nB; ++ui;
        if constexpr (Epi::PRE) E.pre(cur, wr, fr, epre);
        if constexpr (ALIGN_EPI) { if (wr == 1) PG8_BAR; }
    }
    PG8_WAIT_V(0);
    if constexpr (!ALIGN_EPI) { if (wr == 0) PG8_BAR; }
    PG8_BAR;
    if constexpr (Epi::AFTER_DRAIN) { E.fused(acc, cur, wr, wc, fr, fq, lds, wid, lane); S.done(cur); }
#undef PG8_SA
#undef PG8_SB
#undef PG8_STAGE
#undef PG8_LDA
#undef PG8_LDB
#undef PG8_MMA
#undef PG8_WAIT_V
#undef PG8_WAIT_L
#undef PG8_BAR
#undef PG8_SCHED
}
}
#define GAS __attribute__((address_space(1)))
#define LAS __attribute__((address_space(3)))
#define XB_TMO      128
#define XB_XCNT(j)  (256  + 64 * (j))
#define XB_XSUB(j)  (1280 + 64 * (j))
#define XB_XGEN(j)  (2304 + 64 * (j))
#define XB_TOP      3328
#define XB_TOPGEN   3392
#define XCD_BAR_WORDS 3456
#define XB_SPIN_CAP (1u << 18)

__device__ __forceinline__ unsigned xb_ld(unsigned* p)              { return __hip_atomic_load(p, __ATOMIC_RELAXED, __HIP_MEMORY_SCOPE_AGENT); }
__device__ __forceinline__ unsigned xb_add(unsigned* p, unsigned v) { return __hip_atomic_fetch_add(p, v, __ATOMIC_RELAXED, __HIP_MEMORY_SCOPE_AGENT); }
__device__ __forceinline__ unsigned xb_xcc_id() { return (unsigned)__builtin_amdgcn_s_getreg((3 << 11) | 20) & 0xFu; }
#define XB_SPIN(cond, bar) do { unsigned _sp = 0; while (cond) { __builtin_amdgcn_s_sleep(1); \
    if ((++_sp & 255u) == 0u) { if (xb_ld(&(bar)[XB_TMO])) break; if (_sp > XB_SPIN_CAP) { atomicAdd(&(bar)[XB_TMO], 1u); break; } } } } while (0)

struct XcdBarrier {
    unsigned* bar; unsigned x;
    volatile LAS unsigned* st;
};

__device__ __forceinline__ XcdBarrier xcd_barrier_post(unsigned* bar, volatile LAS unsigned* st) {
    XcdBarrier b; b.bar = bar; b.x = xb_xcc_id(); b.st = st;
    if (threadIdx.x == 0) (void)xb_add(&bar[XB_XCNT(b.x)], 1u);
    return b;
}
__device__ __forceinline__ void xcd_barrier_complete(unsigned* bar, unsigned x, unsigned& nloc, unsigned& nx) {
    const unsigned G = gridDim.x * gridDim.y * gridDim.z;
    unsigned sum, cnt, mine, sp = 0u;
    for (;;) {
        sum = 0u; cnt = 0u; mine = 0u;
#pragma unroll
        for (unsigned j = 0; j < 16; ++j) { const unsigned c = xb_ld(&bar[XB_XCNT(j)]); sum += c; cnt += (c > 0u) ? 1u : 0u; mine = (j == x) ? c : mine; }
        if (sum == G) break;
        __builtin_amdgcn_s_sleep(1);
        if ((++sp & 255u) == 0u) { if (xb_ld(&bar[XB_TMO])) break; if (sp > XB_SPIN_CAP) { atomicAdd(&bar[XB_TMO], 1u); break; } }
    }
    nloc = mine > 0u ? mine : 1u; nx = cnt > 0u ? cnt : 1u;
}

__device__ __forceinline__ void xcd_barrier(const XcdBarrier& b) {
    asm volatile("s_waitcnt vmcnt(0)" ::: "memory");
    __syncthreads();
    if (threadIdx.x == 0) {
        unsigned* bar = b.bar;
        __builtin_amdgcn_s_waitcnt(0);
        unsigned nloc = b.st[0], nx = b.st[1];
        if (nloc == 0u) { xcd_barrier_complete(bar, b.x, nloc, nx); b.st[0] = nloc; b.st[1] = nx; }
        const unsigned old = xb_add(&bar[XB_XSUB(b.x)], 1u);
        const unsigned gen = old / nloc;
        if (old + 1u == (gen + 1u) * nloc) {
            __builtin_amdgcn_fence(__ATOMIC_RELEASE, "agent");
            asm volatile("s_waitcnt vmcnt(0)" ::: "memory");
            const unsigned og = xb_add(&bar[XB_TOP], 1u);
            const unsigned tg = og / nx;
            if (og + 1u == (tg + 1u) * nx) xb_add(&bar[XB_TOPGEN], 1u);
            else XB_SPIN(xb_ld(&bar[XB_TOPGEN]) == tg, bar);
            __builtin_amdgcn_fence(__ATOMIC_ACQUIRE, "agent");
            xb_add(&bar[XB_XGEN(b.x)], 1u);
            asm volatile("s_waitcnt vmcnt(0)" ::: "memory");
        } else {
            XB_SPIN(xb_ld(&bar[XB_XGEN(b.x)]) == gen, bar);
            __builtin_amdgcn_fence(__ATOMIC_ACQUIRE, "agent");
            asm volatile("s_waitcnt vmcnt(0)" ::: "memory");
        }
    }
    __syncthreads();
}
constexpr int BATCH = 2, SEQ = 8192, D = 2048, M = BATCH * SEQ, FF = 5632, NIN = 6144, N13 = 2 * FF, CDPITCH = 6152, MODW = 6 * D;
constexpr float EPS = 1e-6f;
#ifndef FFN0_DOWN_FP8
#define FFN0_DOWN_FP8 1
#endif
#ifndef INPROJ0_I8
#define INPROJ0_I8 2
#endif
#ifndef INPROJ1_I8
#define INPROJ1_I8 1
#endif
#ifndef UP1_FP8
#define UP1_FP8 1
#endif
#ifndef OUT1_FP8
#define OUT1_FP8 1
#endif
constexpr float WIN_QW = 1024.f, W13_QW = 1024.f, W2_SCALE = 64.f, WOUT_SCALE = 32.f;
constexpr int NWAVES = 8, NT = NWAVES * 64;
constexpr size_t MiB = 1u << 20;
constexpr size_t WS_CTL = 0, CTL_ZERO_BYTES = 1 * MiB;
constexpr int CW_BAR = 4096; constexpr size_t CTL_KACC = 256 * 1024, CTL_MCNT = 512 * 1024, CTL_MQ = 520 * 1024;
constexpr size_t LW_IN = 0, LW_OUT = 24 * MiB, LW_13 = 32 * MiB, LW_2 = 76 * MiB, LW_SIZE = 98 * MiB;
constexpr size_t WS_W = 1 * MiB;
constexpr size_t WS_SMALL = 197 * MiB;
constexpr size_t SM_SA = 3 * MiB;
constexpr size_t SM_MOD = 0, SM_WAT = 256 * 1024, SM_WXT = 512 * 1024, SM_GATES = 768 * 1024, SM_SUMM = 1280 * 1024, SM_CH = 1792 * 1024, SM_CHS = 1856 * 1024, SM_NST = 2 * MiB;
constexpr size_t WS_XN = 208 * MiB;
constexpr size_t WS_PROJ = 272 * MiB;
constexpr size_t WS_YCAT = 464 * MiB;
constexpr size_t WS_S1 = 528 * MiB;
constexpr size_t WS_S2 = 592 * MiB;
constexpr size_t WS_XB = 656 * MiB;
constexpr size_t WS_END = 720 * MiB;
constexpr int LDS_BYTES = 163840, MISC_OFF = LDS_BYTES - 512;

typedef unsigned short bf16;
typedef unsigned v4u __attribute__((ext_vector_type(4)));
typedef unsigned v2u __attribute__((ext_vector_type(2)));
typedef float f32x4 __attribute__((ext_vector_type(4)));
typedef float f32x16 __attribute__((ext_vector_type(16)));
typedef short bf16x8 __attribute__((ext_vector_type(8)));
typedef short s16x4 __attribute__((ext_vector_type(4)));
typedef short v4i16_t __attribute__((ext_vector_type(4)));
typedef float f32x2_t __attribute__((ext_vector_type(2)));
typedef __bf16 bf16x2_t __attribute__((ext_vector_type(2)));
#define DI __device__ __forceinline__
DI float bf2f(unsigned v) { return __uint_as_float(v << 16); }
DI float bflo(unsigned v) { return __uint_as_float(v << 16); }
DI float bfhi(unsigned v) { return __uint_as_float(v & 0xffff0000u); }
DI unsigned pk2(float lo, float hi) { f32x2_t v = {lo, hi}; bf16x2_t b = __builtin_convertvector(v, bf16x2_t); return __builtin_bit_cast(unsigned, b); }
DI unsigned pack4_i8(float a, float b, float c, float d) { const int ia = (int)rintf(fminf(fmaxf(a, -127.f), 127.f)), ib = (int)rintf(fminf(fmaxf(b, -127.f), 127.f)), ic = (int)rintf(fminf(fmaxf(c, -127.f), 127.f)), id = (int)rintf(fminf(fmaxf(d, -127.f), 127.f));
    return (unsigned)(ia & 0xff) | ((unsigned)(ib & 0xff) << 8) | ((unsigned)(ic & 0xff) << 16) | ((unsigned)id << 24); }
DI float wave_sum(float v) {
#pragma unroll
    for (int o = 1; o < 64; o <<= 1) v += __shfl_xor(v, o);
    return v; }
DI float wave_max(float v) {
#pragma unroll
    for (int o = 1; o < 64; o <<= 1) v = fmaxf(v, __shfl_xor(v, o));
    return v; }
DI int crow(int r, int hi) { return (r & 3) + 8 * (r >> 2) + 4 * hi; }
DI f32x16 mfma32(bf16x8 a, bf16x8 b, f32x16 c) { return __builtin_amdgcn_mfma_f32_32x32x16_bf16(a, b, c, 0, 0, 0); }
DI s16x4 tr_read(LAS unsigned char* p) { return __builtin_bit_cast(s16x4, __builtin_amdgcn_ds_read_tr16_b64_v4i16((LAS v4i16_t*)p)); }
DI bf16x8 tr_frag(LAS unsigned char* base, int pitch, int r0, int r1, int cbyte, int q) {
    const s16x4 lo = tr_read(base + (r0 + q) * pitch + cbyte), hi = tr_read(base + (r1 + q) * pitch + cbyte);
    return __builtin_shufflevector(lo, hi, 0, 1, 2, 3, 4, 5, 6, 7); }
DI float fexp(float x) { return __builtin_amdgcn_exp2f(1.4426950408889634f * x); }
DI float sigmoid_f(float x) { return __builtin_amdgcn_rcpf(1.0f + fexp(-x)); }
DI float gelu_tanh(float x) { const float u = 0.7978845608f * (x + 0.044715f * x * x * x); const float th = 1.0f - 2.0f * __builtin_amdgcn_rcpf(fexp(2.0f * u) + 1.0f); return 0.5f * x * (1.0f + th); }
DI float log_sigmoid_f(float f) { return f >= 0.f ? -log1pf(fexp(-f)) : f - log1pf(fexp(f)); }
DI void wg_sync() { asm volatile("s_waitcnt lgkmcnt(0)" ::: "memory"); __builtin_amdgcn_s_barrier(); asm volatile("" ::: "memory"); }
#define ZERO16(v) do { _Pragma("unroll") for (int _z = 0; _z < 16; ++_z) (v)[_z] = 0.f; } while (0)

struct Args { const float* in[23]; float* out; unsigned char* ws; };
struct Ctx { LAS unsigned char* lds; int tid, lane, wave, G, bid, gw, ngw; };
DI Ctx fresh(const Ctx& C0) { Ctx C = C0; int t = C0.tid; asm volatile("" : "+v"(t)); C.tid = t; C.lane = t & 63; C.wave = __builtin_amdgcn_readfirstlane(t >> 6); C.gw = C.bid * NWAVES + C.wave; return C; }

DI void p0_transpose_item(const float* W, int pitch, int K, bf16* WT, int k0, int n0, int drow0, LAS float* scr, int lane) {
    float rr[32]; const float* wp = W + (size_t)(k0 + (lane >> 5)) * pitch + n0 + (lane & 31);
#pragma unroll
    for (int i = 0; i < 32; ++i) rr[i] = __builtin_nontemporal_load(wp + (size_t)(2 * i) * pitch);
#pragma unroll
    for (int i = 0; i < 32; ++i) scr[(2 * i + (lane >> 5)) * 33 + (lane & 31)] = rr[i];
    asm volatile("s_waitcnt lgkmcnt(0)" ::: "memory");
    const int c = lane & 7;
#pragma unroll
    for (int j = 0; j < 4; ++j) { const int n = (lane >> 3) + 8 * j; const LAS float* s = scr + (8 * c) * 33 + n;
        v4u o; o.x = pk2(s[0 * 33], s[1 * 33]); o.y = pk2(s[2 * 33], s[3 * 33]); o.z = pk2(s[4 * 33], s[5 * 33]); o.w = pk2(s[6 * 33], s[7 * 33]);
        *(v4u*)(WT + (size_t)(drow0 + n) * K + k0 + 8 * c) = o; }
    asm volatile("s_waitcnt lgkmcnt(0)" ::: "memory");
}
template <bool I8>
DI void p0_transpose_item8(const float* W, int pitch, int K, unsigned char* WT, int k0, int n0, int drow0, float sc, LAS float* scr, int lane) {
    float rr[32]; const float* wp = W + (size_t)(k0 + (lane >> 5)) * pitch + n0 + (lane & 31);
#pragma unroll
    for (int i = 0; i < 32; ++i) rr[i] = __builtin_nontemporal_load(wp + (size_t)(2 * i) * pitch);
#pragma unroll
    for (int i = 0; i < 32; ++i) scr[(2 * i + (lane >> 5)) * 33 + (lane & 31)] = rr[i];
    asm volatile("s_waitcnt lgkmcnt(0)" ::: "memory");
    const int c = lane & 7;
#pragma unroll
    for (int j = 0; j < 4; ++j) { const int n = (lane >> 3) + 8 * j; const LAS float* s = scr + (8 * c) * 33 + n;
        v2u o; if (I8) { o.x = pack4_i8(s[0 * 33] * sc, s[1 * 33] * sc, s[2 * 33] * sc, s[3 * 33] * sc); o.y = pack4_i8(s[4 * 33] * sc, s[5 * 33] * sc, s[6 * 33] * sc, s[7 * 33] * sc); }
        else { o.x = pg8::cvt4_fp8(s[0 * 33] * sc, s[1 * 33] * sc, s[2 * 33] * sc, s[3 * 33] * sc); o.y = pg8::cvt4_fp8(s[4 * 33] * sc, s[5 * 33] * sc, s[6 * 33] * sc, s[7 * 33] * sc); }
        *(v2u*)(WT + (size_t)(drow0 + n) * K + k0 + 8 * c) = o; }
    asm volatile("s_waitcnt lgkmcnt(0)" ::: "memory");
}
DI void p0_prologue(const Args& a, const Ctx& C) {
    LAS float* cond = (LAS float*)(C.lds + 131072);
#pragma unroll
    for (int ii = 0; ii < 2 * D / NT; ++ii) { const int i = C.tid + NT * ii; const float v = a.in[1][i]; cond[i] = v / (1.0f + fexp(-v)); }
    wg_sync();
    float* MOD = (float*)(a.ws + WS_SMALL + SM_MOD);
    if (C.gw < 768) {
        const int layer = C.gw / 384, col0 = (C.gw % 384) * 32, rs = C.lane >> 3, cq = C.lane & 7;
        const float* Wm = a.in[2] + (size_t)layer * D * MODW + col0 + 4 * cq;
        f32x4 a0 = {0.f, 0.f, 0.f, 0.f}, a1 = {0.f, 0.f, 0.f, 0.f};
#pragma unroll 16
        for (int k = 0; k < D; k += 8) { const int row = k + rs; const f32x4 w = __builtin_nontemporal_load((const f32x4*)(Wm + (size_t)row * MODW)); a0 += cond[row] * w; a1 += cond[D + row] * w; }
#pragma unroll
        for (int o = 8; o < 64; o <<= 1) {
#pragma unroll
            for (int i = 0; i < 4; ++i) { a0[i] += __shfl_xor(a0[i], o); a1[i] += __shfl_xor(a1[i], o); } }
        if (C.lane < 8) { const f32x4 bb = *(const f32x4*)(a.in[3] + (size_t)layer * MODW + col0 + 4 * cq);
            *(f32x4*)(MOD + ((size_t)layer * 2 + 0) * MODW + col0 + 4 * cq) = a0 + bb; *(f32x4*)(MOD + ((size_t)layer * 2 + 1) * MODW + col0 + 4 * cq) = a1 + bb; }
    }
    LAS float* scr = (LAS float*)(C.lds + C.wave * 16384);
    constexpr int I_IN = 32 * 192, I_OUT = 32 * 64, I_1 = 32 * 176, I_2 = 88 * 64, I_L = I_IN + I_OUT + 2 * I_1 + I_2, I_ALL = 2 * I_L + 128;
    for (int it = C.gw; it < I_ALL; it += C.ngw) {
        if (it >= 2 * I_L) {
            const int r = it - 2 * I_L, mat = r >> 6, g = (r >> 3) & 7, sub = r & 7, kb = sub >> 2, nb = sub & 3;
            const float* W = (mat ? a.in[18] : a.in[16]) + g * 16384; bf16* WT = (bf16*)(a.ws + WS_SMALL + (mat ? SM_WXT : SM_WAT)) + g * 16384;
            p0_transpose_item(W, 128, 128, WT, 64 * kb, 32 * nb, 32 * nb, scr, C.lane); continue; }
        const int layer = it / I_L; int r = it % I_L; unsigned char* wl = a.ws + WS_W + (size_t)layer * LW_SIZE;
        if (r < I_IN) { const int kb = r / 192, nb = r % 192; if (!layer && INPROJ0_I8 && (INPROJ0_I8 == 1 || nb < 96)) p0_transpose_item8<true>(a.in[9], NIN, D, wl + LW_IN, 64 * kb, 32 * nb, 32 * nb, WIN_QW, scr, C.lane);
            else if (layer && INPROJ1_I8 && (nb < 64 || nb >= 128)) p0_transpose_item8<true>(a.in[12], CDPITCH, D, wl + LW_IN, 64 * kb, 32 * nb, nb < 64 ? 32 * nb : 32 * nb - 2048, WIN_QW, scr, C.lane);
            else p0_transpose_item(layer ? a.in[12] : a.in[9], layer ? CDPITCH : NIN, D, (bf16*)(wl + LW_IN), 64 * kb, 32 * nb, 32 * nb, scr, C.lane); continue; } r -= I_IN;
        if (r < I_OUT) { const int kb = r / 64, nb = r % 64; if (layer && OUT1_FP8) p0_transpose_item8<false>(a.in[21], D, D, wl + LW_OUT, 64 * kb, 32 * nb, 32 * nb, WOUT_SCALE, scr, C.lane);
            else p0_transpose_item(layer ? a.in[21] : a.in[11], D, D, (bf16*)(wl + LW_OUT), 64 * kb, 32 * nb, 32 * nb, scr, C.lane); continue; } r -= I_OUT;
        if (r < 2 * I_1) { const int w3 = r >= I_1; if (w3) r -= I_1; const int kb = r / 176, nb = r % 176, n0 = 32 * nb;
            const float* W = (w3 ? a.in[7] : a.in[6]) + (size_t)layer * D * FF; const int dr = (n0 >> 7) * 256 + (n0 & 127) + (w3 ? 128 : 0);
            if (layer && UP1_FP8) p0_transpose_item8<false>(W, FF, D, wl + LW_13, 64 * kb, n0, dr, 64.0f, scr, C.lane); else p0_transpose_item8<true>(W, FF, D, wl + LW_13, 64 * kb, n0, dr, W13_QW, scr, C.lane); continue; } r -= 2 * I_1;
        { const int kb = r / 64, nb = r % 64; const float* W = a.in[8] + (size_t)layer * FF * D;
          if (layer || FFN0_DOWN_FP8) p0_transpose_item8<false>(W, D, FF, wl + LW_2, 64 * kb, 32 * nb, 32 * nb, W2_SCALE, scr, C.lane); else p0_transpose_item(W, D, FF, (bf16*)(wl + LW_2), 64 * kb, 32 * nb, 32 * nb, scr, C.lane); }
    }
}

template <bool GATES, int OUTM, bool SRCB>
DI void norm_phase(const void* src, const float* gain, const float* sh, const float* sc, bf16* dst, const float* wg, const float* gate_b, float* gates, float* sa, const Ctx& C, unsigned char* dst8 = nullptr, bf16* xcopy = nullptr) {
    LAS float* WG = (LAS float*)C.lds;
    if (GATES) {
#pragma unroll 8
        for (int i = 0; i < 8 * D / NT; ++i) { const int idx = C.tid + NT * i, k = idx >> 3, j = idx & 7; WG[j * D + (k & ~511) + 256 * ((k >> 2) & 1) + 4 * ((k & 511) >> 3) + (k & 3)] = wg[(size_t)k * CDPITCH + NIN + j]; }
        wg_sync(); }
    int curb = -1; f32x4 A[8], B[8];
    for (int m = C.gw; m < M; m += C.ngw) {
        const int b = m >> 13;
        if (b != curb) { curb = b;
#pragma unroll
            for (int j = 0; j < 8; ++j) { const int col = 8 * C.lane + 512 * (j >> 1) + 4 * (j & 1); const f32x4 g = *(const f32x4*)(gain + col), s1 = *(const f32x4*)(sc + (size_t)b * MODW + col); A[j] = g * (1.0f + s1); B[j] = *(const f32x4*)(sh + (size_t)b * MODW + col); } }
        f32x4 v[8]; float ss = 0.f;
        if (SRCB) { const v4u* xr = (const v4u*)((const bf16*)src + (size_t)m * D) + C.lane;
#pragma unroll
            for (int g = 0; g < 4; ++g) { const v4u r = xr[64 * g]; v[2 * g] = (f32x4){bflo(r.x), bfhi(r.x), bflo(r.y), bfhi(r.y)}; v[2 * g + 1] = (f32x4){bflo(r.z), bfhi(r.z), bflo(r.w), bfhi(r.w)}; } }
        else { const f32x4* xr = (const f32x4*)((const float*)src + (size_t)m * D) + 2 * C.lane;
#pragma unroll
            for (int j = 0; j < 8; ++j) v[j] = xr[128 * (j >> 1) + (j & 1)];
            if (xcopy) { v4u* xc = (v4u*)(xcopy + (size_t)m * D) + C.lane;
#pragma unroll
                for (int g = 0; g < 4; ++g) { v4u w; w.x = pk2(v[2 * g].x, v[2 * g].y); w.y = pk2(v[2 * g].z, v[2 * g].w); w.z = pk2(v[2 * g + 1].x, v[2 * g + 1].y); w.w = pk2(v[2 * g + 1].z, v[2 * g + 1].w); xc[64 * g] = w; } } }
#pragma unroll
        for (int j = 0; j < 8; ++j) ss += (v[j].x * v[j].x + v[j].y * v[j].y) + (v[j].z * v[j].z + v[j].w * v[j].w);
        const float rstd = 1.0f / sqrtf(wave_sum(ss) * (1.0f / D) + EPS);
        v4u* o16 = (v4u*)(dst + (size_t)m * D) + C.lane; v2u* o8 = (v2u*)((OUTM == 3 ? dst8 : (unsigned char*)dst) + (size_t)m * D) + C.lane;
#pragma unroll
        for (int j = 0; j < 8; ++j) v[j] = v[j] * rstd * A[j] + B[j];
        if (OUTM >= 2) { float am = 0.f;
#pragma unroll
            for (int j = 0; j < 8; ++j) am = fmaxf(am, fmaxf(fmaxf(fabsf(v[j].x), fabsf(v[j].y)), fmaxf(fabsf(v[j].z), fabsf(v[j].w))));
            am = fmaxf(wave_max(am), 1e-20f); const float qi = 127.0f / am; if (C.lane == 0) sa[m] = am * (1.0f / 127.0f);
#pragma unroll
            for (int g = 0; g < 4; ++g) { v2u w; w.x = pack4_i8(v[2 * g].x * qi, v[2 * g].y * qi, v[2 * g].z * qi, v[2 * g].w * qi); w.y = pack4_i8(v[2 * g + 1].x * qi, v[2 * g + 1].y * qi, v[2 * g + 1].z * qi, v[2 * g + 1].w * qi); o8[64 * g] = w; } }
        if (OUTM == 1) {
#pragma unroll
            for (int g = 0; g < 4; ++g) { v2u w; w.x = pg8::cvt4_fp8(v[2 * g].x, v[2 * g].y, v[2 * g].z, v[2 * g].w); w.y = pg8::cvt4_fp8(v[2 * g + 1].x, v[2 * g + 1].y, v[2 * g + 1].z, v[2 * g + 1].w); o8[64 * g] = w; } }
        if (OUTM == 0 || OUTM == 3) {
#pragma unroll
            for (int g = 0; g < 4; ++g) { v4u w; w.x = pk2(v[2 * g].x, v[2 * g].y); w.y = pk2(v[2 * g].z, v[2 * g].w); w.z = pk2(v[2 * g + 1].x, v[2 * g + 1].y); w.w = pk2(v[2 * g + 1].z, v[2 * g + 1].w); o16[64 * g] = w; } }
        if (GATES) {
#pragma unroll 1
            for (int g = 0; g < 8; ++g) { float p = 0.f;
#pragma unroll
                for (int j = 0; j < 8; ++j) { const f32x4 w = *(const LAS f32x4*)(WG + g * D + 512 * (j >> 1) + 256 * (j & 1) + 4 * C.lane); p += (v[j].x * w.x + v[j].y * w.y) + (v[j].z * w.z + v[j].w * w.w); }
                p = wave_sum(p); if (C.lane == g) gates[(size_t)m * 8 + g] = p + gate_b[g]; } }
    }
    if (GATES) wg_sync();
}
DI void final_norm(const bf16* xb, float* x, const float* gain, const Ctx& C) {
    f32x4 A[8];
#pragma unroll
    for (int j = 0; j < 8; ++j) A[j] = *(const f32x4*)(gain + 8 * C.lane + 512 * (j >> 1) + 4 * (j & 1));
    for (int m = C.gw; m < M; m += C.ngw) {
        f32x4* xr = (f32x4*)(x + (size_t)m * D) + 2 * C.lane; const v4u* xs = (const v4u*)(xb + (size_t)m * D) + C.lane; f32x4 v[8]; float ss = 0.f;
#pragma unroll
        for (int g = 0; g < 4; ++g) { const v4u r = xs[64 * g]; v[2 * g] = (f32x4){bflo(r.x), bfhi(r.x), bflo(r.y), bfhi(r.y)}; v[2 * g + 1] = (f32x4){bflo(r.z), bfhi(r.z), bflo(r.w), bfhi(r.w)}; }
#pragma unroll
        for (int j = 0; j < 8; ++j) ss += (v[j].x * v[j].x + v[j].y * v[j].y) + (v[j].z * v[j].z + v[j].w * v[j].w);
        const float rstd = 1.0f / sqrtf(wave_sum(ss) * (1.0f / D) + EPS);
#pragma unroll
        for (int j = 0; j < 8; ++j) xr[128 * (j >> 1) + (j & 1)] = v[j] * rstd * A[j];
    }
}

DI void conv_phase(const bf16* PROJ, const float* cw  , bf16* YCAT, const Ctx& C) {
    constexpr int TOT = (M / 4) * 128; const int stride = C.G * NT;
    for (int it = C.bid * NT + C.tid; it < TOT; it += stride) {
        const int m0 = (it >> 7) * 4, ch = (it & 127) * 8; const bool head = (m0 & (SEQ - 1)) == 0;
        v4u gc[6], xb[6], gb[4];
#pragma unroll
        for (int r = 0; r < 6; ++r) { const int mm = (head && r < 2) ? m0 : m0 - 2 + r; const bf16* rp = PROJ + (size_t)mm * NIN; gc[r] = *(const v4u*)(rp + 4096 + ch); xb[r] = *(const v4u*)(rp + 5120 + ch); }
#pragma unroll
        for (int r = 0; r < 4; ++r) gb[r] = *(const v4u*)(PROJ + (size_t)(m0 + r) * NIN + 3072 + ch);
        f32x4 w[3][2];
#pragma unroll
        for (int j = 0; j < 3; ++j) { w[j][0] = *(const f32x4*)(cw + j * 1024 + ch); w[j][1] = *(const f32x4*)(cw + j * 1024 + ch + 4); }
        float pr[6][8];
#pragma unroll
        for (int r = 0; r < 6; ++r) { const bool ok = !(head && r < 2);
            pr[r][0] = ok ? bflo(gc[r].x) * bflo(xb[r].x) : 0.f; pr[r][1] = ok ? bfhi(gc[r].x) * bfhi(xb[r].x) : 0.f; pr[r][2] = ok ? bflo(gc[r].y) * bflo(xb[r].y) : 0.f; pr[r][3] = ok ? bfhi(gc[r].y) * bfhi(xb[r].y) : 0.f;
            pr[r][4] = ok ? bflo(gc[r].z) * bflo(xb[r].z) : 0.f; pr[r][5] = ok ? bfhi(gc[r].z) * bfhi(xb[r].z) : 0.f; pr[r][6] = ok ? bflo(gc[r].w) * bflo(xb[r].w) : 0.f; pr[r][7] = ok ? bfhi(gc[r].w) * bfhi(xb[r].w) : 0.f; }
#pragma unroll
        for (int r = 0; r < 4; ++r) { float acc[8];
#pragma unroll
            for (int i = 0; i < 8; ++i) { acc[i] = 0.f;
#pragma unroll
                for (int j = 0; j < 3; ++j) acc[i] += w[j][i >> 2][i & 3] * pr[r + j][i]; }
            const v4u g = gb[r]; v4u o; o.x = pk2(acc[0] * bflo(g.x), acc[1] * bfhi(g.x)); o.y = pk2(acc[2] * bflo(g.y), acc[3] * bfhi(g.y)); o.z = pk2(acc[4] * bflo(g.z), acc[5] * bfhi(g.z)); o.w = pk2(acc[6] * bflo(g.w), acc[7] * bfhi(g.w));
            *(v4u*)(YCAT + (size_t)(m0 + r) * D + 1024 + ch) = o; }
    }
}
DI void moba_gate_unit(const bf16* PROJ, const float* kacc, unsigned* CNT, unsigned* LIST, int b, int h, int j, const Ctx& C) {
    constexpr int KMH = 0, KML = 8704, PITCH = 272;
    LAS unsigned char* lds = C.lds;
    const int l31 = C.lane & 31, h2 = C.lane >> 5;
    const int t = j * 256 + 32 * C.wave + l31; const size_t m = (size_t)b * SEQ + t; const int bh = b * 8 + h;
    { const int n = C.tid >> 4, dc = C.tid & 15; const float* kp = kacc + (size_t)(b * 32 + n) * 1024 + 128 * h + 8 * dc; const f32x4 x0 = *(const f32x4*)kp * (1.0f / 256.0f), x1 = *(const f32x4*)(kp + 4) * (1.0f / 256.0f);
      v4u hi; hi.x = pk2(x0.x, x0.y); hi.y = pk2(x0.z, x0.w); hi.z = pk2(x1.x, x1.y); hi.w = pk2(x1.z, x1.w);
      v4u lo; lo.x = pk2(x0.x - bflo(hi.x), x0.y - bfhi(hi.x)); lo.y = pk2(x0.z - bflo(hi.y), x0.w - bfhi(hi.y)); lo.z = pk2(x1.x - bflo(hi.z), x1.y - bfhi(hi.z)); lo.w = pk2(x1.z - bflo(hi.w), x1.w - bfhi(hi.w));
      *(LAS v4u*)(lds + KMH + n * PITCH + dc * 16) = hi; *(LAS v4u*)(lds + KML + n * PITCH + dc * 16) = lo; }
    LAS unsigned* cntl = (LAS unsigned*)(lds + 17408); LAS unsigned* basel = cntl + 32;
    if (C.tid < 32) cntl[C.tid] = 0u;
    bf16x8 Q[8];
#pragma unroll
    for (int ks = 0; ks < 8; ++ks) Q[ks] = *(const bf16x8*)(PROJ + m * NIN + 128 * h + 16 * ks + 8 * h2);
    wg_sync();
    f32x16 g; ZERO16(g);
#pragma unroll
    for (int ks = 0; ks < 8; ++ks) { const int kb = (16 * ks + 8 * h2) * 2; const bf16x8 Ah = *(const LAS bf16x8*)(lds + KMH + l31 * PITCH + kb), Al = *(const LAS bf16x8*)(lds + KML + l31 * PITCH + kb);
        g = mfma32(Ah, Q[ks], g); g = mfma32(Al, Q[ks], g); }
#pragma unroll
    for (int i = 0; i < 16; ++i) if (crow(i, h2) >= j) g[i] = -INFINITY;
    int seln[3]; unsigned lpos[3];
#pragma unroll
    for (int r = 0; r < 3; ++r) { float best = -INFINITY; int bidx = 99; seln[r] = -1; lpos[r] = 0u;
#pragma unroll
        for (int i = 0; i < 16; ++i) if (g[i] > best) { best = g[i]; bidx = crow(i, h2); }
        const float pb = __shfl_xor(best, 32); const int pi = __shfl_xor(bidx, 32);
        if (pb > best || (pb == best && pi < bidx)) { best = pb; bidx = pi; }
        if (best > -1e37f) { seln[r] = bidx;
            if (h2 == 0) lpos[r] = __hip_atomic_fetch_add(cntl + bidx, 1u, __ATOMIC_RELAXED, __HIP_MEMORY_SCOPE_WORKGROUP);
#pragma unroll
            for (int i = 0; i < 16; ++i) if (crow(i, h2) == bidx) g[i] = -INFINITY; } }
    wg_sync();
    if (C.tid < 32) { const unsigned c = cntl[C.tid]; basel[C.tid] = c ? __hip_atomic_fetch_add(CNT + bh * 32 + C.tid, c, __ATOMIC_RELAXED, __HIP_MEMORY_SCOPE_AGENT) : 0u; }
    wg_sync();
    if (h2 == 0) {
#pragma unroll
        for (int r = 0; r < 3; ++r) if (seln[r] >= 0) LIST[(size_t)(bh * 32 + seln[r]) * 8192 + basel[seln[r]] + lpos[r]] = (unsigned)t | ((unsigned)r << 16); }
    wg_sync();
}
template <bool OWN>
DI void moba_tile(LAS unsigned char* lds, const bf16* PROJ, bf16* PART, float* ML, int b, int h, int n, int t, bool valid, int slot, int nchunks, const Ctx& C) {
    constexpr int KB = 0, VB = 69632, EB = 139264, PITCH = 272;
    const int l31 = C.lane & 31, h2 = C.lane >> 5, blk = (C.lane >> 4) & 1, q = (C.lane & 15) >> 2, p = C.lane & 3;
    const size_t m = (size_t)b * SEQ + t; const int qi = t & 255;
    const float c1 = 0.08838834764831845f * 1.4426950408889634f, sl2 = exp2f(-(float)(h + 1)) * 1.4426950408889634f;
    bf16x8 Q[8];
#pragma unroll
    for (int ks = 0; ks < 8; ++ks) { const v4u r = *(const v4u*)(PROJ + m * NIN + 128 * h + 16 * ks + 8 * h2); v4u w;
        w.x = pk2(bflo(r.x) * c1, bfhi(r.x) * c1); w.y = pk2(bflo(r.y) * c1, bfhi(r.y) * c1); w.z = pk2(bflo(r.z) * c1, bfhi(r.z) * c1); w.w = pk2(bflo(r.w) * c1, bfhi(r.w) * c1); Q[ks] = __builtin_bit_cast(bf16x8, w); }
    v4u qxw = {h2 == 0 ? 0x3F803F80u : 0u, 0u, 0u, 0u}; const bf16x8 Qx = __builtin_bit_cast(bf16x8, qxw);
    f32x16 O[4];
#pragma unroll
    for (int i = 0; i < 4; ++i) ZERO16(O[i]);
    float mrun = -INFINITY, lrun = 0.f;
#pragma unroll 1
    for (int cc = 0; cc < nchunks; ++cc) {
        const int kbase = (OWN ? cc : 3 - cc) * 64;
        f32x16 S0, S1; ZERO16(S0); ZERO16(S1);
        { bf16x8 KA[9], KB2[9];
          constexpr int KDEPTH = 3;
#define MOBA_LDK(ks_) do { if ((ks_) < 8) { const int kb_ = (16 * (ks_) + 8 * h2) * 2; KA[ks_] = *(const LAS bf16x8*)(lds + KB + (kbase + l31) * PITCH + kb_); KB2[ks_] = *(const LAS bf16x8*)(lds + KB + (kbase + 32 + l31) * PITCH + kb_); } \
            else { KA[8] = *(const LAS bf16x8*)(lds + EB + (kbase + l31) * 32 + h2 * 16); KB2[8] = *(const LAS bf16x8*)(lds + EB + (kbase + 32 + l31) * 32 + h2 * 16); } } while (0)
#pragma unroll
          for (int ks = 0; ks < KDEPTH; ++ks) MOBA_LDK(ks);
          __builtin_amdgcn_sched_barrier(0);
#pragma unroll
          for (int ks = 0; ks < 9; ++ks) { if (ks + KDEPTH < 9) MOBA_LDK(ks + KDEPTH);
              if (ks < 8) { S0 = mfma32(KA[ks], Q[ks], S0); S1 = mfma32(KB2[ks], Q[ks], S1); } else { S0 = mfma32(KA[8], Qx, S0); S1 = mfma32(KB2[8], Qx, S1); }
              __builtin_amdgcn_sched_barrier(0); }
#undef MOBA_LDK
        }
        if (OWN) { const int lim = qi - kbase - 4 * h2;
#pragma unroll
            for (int i = 0; i < 16; ++i) { const int ci = (i & 3) + 8 * (i >> 2); if (ci > lim) S0[i] = -INFINITY; if (ci + 32 > lim) S1[i] = -INFINITY; } }
        float mx = fmaxf(S0[0], S1[0]);
#pragma unroll
        for (int i = 1; i < 16; ++i) mx = fmaxf(mx, fmaxf(S0[i], S1[i]));
        mx = fmaxf(mx, __shfl_xor(mx, 32));
        const float mnew = fmaxf(mrun, mx);
        if (__ballot(mnew > mrun) != 0ull) { const float alpha = __builtin_amdgcn_exp2f(mrun - mnew); lrun *= alpha;
#pragma unroll
            for (int et = 0; et < 4; ++et) O[et] = O[et] * alpha; }
        mrun = mnew; float ps = 0.f;
#pragma unroll
        for (int i = 0; i < 16; ++i) { S0[i] = __builtin_amdgcn_exp2f(S0[i] - mnew); S1[i] = __builtin_amdgcn_exp2f(S1[i] - mnew); ps += S0[i] + S1[i]; }
        lrun += ps;
#pragma unroll
        for (int s2 = 0; s2 < 4; ++s2) { v4u pw;
            if (s2 < 2) { pw.x = pk2(S0[8 * s2], S0[8 * s2 + 1]); pw.y = pk2(S0[8 * s2 + 2], S0[8 * s2 + 3]); pw.z = pk2(S0[8 * s2 + 4], S0[8 * s2 + 5]); pw.w = pk2(S0[8 * s2 + 6], S0[8 * s2 + 7]); }
            else { pw.x = pk2(S1[8 * s2 - 16], S1[8 * s2 - 15]); pw.y = pk2(S1[8 * s2 - 14], S1[8 * s2 - 13]); pw.z = pk2(S1[8 * s2 - 12], S1[8 * s2 - 11]); pw.w = pk2(S1[8 * s2 - 10], S1[8 * s2 - 9]); }
            const bf16x8 Pf = __builtin_bit_cast(bf16x8, pw); const int r0 = kbase + 16 * s2 + 4 * h2;
#pragma unroll
            for (int et = 0; et < 4; ++et) { const bf16x8 A = tr_frag(lds + VB, PITCH, r0, r0 + 8, (32 * et + 16 * blk + 4 * p) * 2, q); O[et] = mfma32(A, Pf, O[et]); } }
    }
    const float ltot = lrun + __shfl_xor(lrun, 32), inv = 1.0f / ltot;
    if (valid) { const size_t prow = ((size_t)(b * 8 + h) * 8192 + t) * 4 + slot; bf16* op = PART + prow * 128;
#pragma unroll
        for (int et = 0; et < 4; ++et)
#pragma unroll
            for (int g2 = 0; g2 < 4; ++g2) { v2u o; o.x = pk2(O[et][4 * g2] * inv, O[et][4 * g2 + 1] * inv); o.y = pk2(O[et][4 * g2 + 2] * inv, O[et][4 * g2 + 3] * inv); *(v2u*)(op + 32 * et + 8 * g2 + 4 * h2) = o; }
        if (h2 == 0) { ML[prow * 2] = mrun - sl2 * (float)(t - 256 * n); ML[prow * 2 + 1] = ltot; } }
}
DI void moba_work_phase(const bf16* PROJ, const unsigned* CNT, const unsigned* LIST, unsigned* QCTR, bf16* PART, float* ML, const Ctx& C) {
    constexpr int NA = 31 * 64, NU = NA + 16, PITCH = 272;
    LAS unsigned char* lds = C.lds; volatile LAS unsigned* nxt = (volatile LAS unsigned*)(lds + 147456);
    if (C.tid == 0) nxt[0] = __hip_atomic_fetch_add(QCTR, 1u, __ATOMIC_RELAXED, __HIP_MEMORY_SCOPE_AGENT);
    for (;;) {
        wg_sync();
        const int ui = (int)nxt[0];
        wg_sync();
        if (ui >= NU) break;
        unsigned pre = 0u; if (C.tid == 0) pre = __hip_atomic_fetch_add(QCTR, 1u, __ATOMIC_RELAXED, __HIP_MEMORY_SCOPE_AGENT);
        int b, h, n, tile0 = 0, tile1 = 0; unsigned cnt = 0; bool own = true;
        if (ui < NA) { n = ui >> 6; const int bh = (ui >> 2) & 15, part = ui & 3; b = bh >> 3; h = bh & 7; cnt = CNT[bh * 32 + n]; const int ntiles = (int)((cnt + 31u) >> 5), tp4 = (ntiles + 3) >> 2, tp = (tp4 + 7) & ~7;     tile0 = tp * part; tile1 = tile0 + tp < ntiles ? tile0 + tp : ntiles; own = part == 0; if (!own && tile0 >= ntiles) { if (C.tid == 0) nxt[0] = pre; continue; } }
        else { const int bh = ui - NA; n = 31; b = bh >> 3; h = bh & 7; }
        { const size_t row0 = (size_t)b * SEQ + n * 256;
#pragma unroll
          for (int i = 0; i < 8; ++i) { const int idx = C.tid + NT * i; const bf16* rp = PROJ + (row0 + (idx >> 4)) * NIN + 128 * h + 8 * (idx & 15);
              *(LAS v4u*)(lds + (idx >> 4) * PITCH + (idx & 15) * 16) = *(const v4u*)(rp + 1024); *(LAS v4u*)(lds + 69632 + (idx >> 4) * PITCH + (idx & 15) * 16) = *(const v4u*)(rp + 2048); }
          if (C.tid < 256) { const float x = exp2f(-(float)(h + 1)) * 1.4426950408889634f * (float)C.tid; const unsigned hi = pk2(x, 0.f) & 0xffffu; const unsigned lo = pk2(x - bflo(hi), 0.f) & 0xffffu;
              v4u e0 = {hi | (lo << 16), 0u, 0u, 0u}, e1 = {0u, 0u, 0u, 0u}; *(LAS v4u*)(lds + 139264 + C.tid * 32) = e0; *(LAS v4u*)(lds + 139264 + C.tid * 32 + 16) = e1; } }
        wg_sync();
        { const unsigned* lp = LIST + (size_t)((b * 8 + h) * 32 + n) * 8192;
          for (int tile = tile0 + C.wave; tile < tile1; tile += 8) { const unsigned e = 32u * tile + (C.lane & 31); const bool valid = e < cnt; const unsigned ent = lp[valid ? e : 32u * tile];
              moba_tile<false>(lds, PROJ, PART, ML, b, h, n, (int)(ent & 0xffffu), valid, (int)(ent >> 16), 4, C); } }
        if (own) moba_tile<true>(lds, PROJ, PART, ML, b, h, n, n * 256 + 32 * C.wave + (C.lane & 31), true, 3, (32 * C.wave + 31) / 64 + 1, C);
        if (C.tid == 0) nxt[0] = pre;
    }
}
DI void moba_merge_phase(const bf16* PART, const float* ML, bf16* YCAT, const Ctx& C) {
    constexpr int TOT = 131072 * 16; const int stride = C.G * NT;
    for (int it0 = C.bid * NT + C.tid; it0 < TOT; it0 += 4 * stride) {
        f32x4 ml[4][2]; v4u pv[4][4];
#pragma unroll
        for (int k = 0; k < 4; ++k) { const int it = it0 + k * stride, itc = it < TOT ? it : TOT - 1, row = itc >> 4, ec = (itc & 15) * 8;
            ml[k][0] = *(const f32x4*)(ML + (size_t)row * 8); ml[k][1] = *(const f32x4*)(ML + (size_t)row * 8 + 4);
#pragma unroll
            for (int s = 0; s < 4; ++s) pv[k][s] = *(const v4u*)(PART + ((size_t)row * 4 + s) * 128 + ec); }
#pragma unroll
        for (int k = 0; k < 4; ++k) { const int it = it0 + k * stride, itc = it < TOT ? it : TOT - 1, row = itc >> 4, ec = (itc & 15) * 8, t = row & 8191, bh = row >> 13, j = t >> 8, nsel = j < 3 ? j : 3;
            float mm[4], ll[4];
            mm[0] = nsel > 0 ? ml[k][0].x : -INFINITY; ll[0] = nsel > 0 ? ml[k][0].y : 0.f; mm[1] = nsel > 1 ? ml[k][0].z : -INFINITY; ll[1] = nsel > 1 ? ml[k][0].w : 0.f;
            mm[2] = nsel > 2 ? ml[k][1].x : -INFINITY; ll[2] = nsel > 2 ? ml[k][1].y : 0.f; mm[3] = ml[k][1].z; ll[3] = ml[k][1].w;
            const float Mx = fmaxf(fmaxf(mm[0], mm[1]), fmaxf(mm[2], mm[3]));
            float acc[8], W = 0.f;
#pragma unroll
            for (int i = 0; i < 8; ++i) acc[i] = 0.f;
#pragma unroll
            for (int s = 0; s < 4; ++s) { const bool ok = (s == 3) || (s < nsel); const float w = ok ? ll[s] * __builtin_amdgcn_exp2f(mm[s] - Mx) : 0.f; W += w;
                v4u v = pv[k][s]; if (!ok) v = (v4u){0u, 0u, 0u, 0u};
                acc[0] += w * bflo(v.x); acc[1] += w * bfhi(v.x); acc[2] += w * bflo(v.y); acc[3] += w * bfhi(v.y); acc[4] += w * bflo(v.z); acc[5] += w * bfhi(v.z); acc[6] += w * bflo(v.w); acc[7] += w * bfhi(v.w); }
            const float inv = 1.0f / W; v4u o; o.x = pk2(acc[0] * inv, acc[1] * inv); o.y = pk2(acc[2] * inv, acc[3] * inv); o.z = pk2(acc[4] * inv, acc[5] * inv); o.w = pk2(acc[6] * inv, acc[7] * inv);
            if (it < TOT) *(v4u*)(YCAT + ((size_t)(bh >> 3) * SEQ + t) * D + 128 * (bh & 7) + ec) = o; }
    }
}

DI void rg_step1_unit(const bf16* PROJ, const bf16* waT, const bf16* wxT, const float* cw, const float* cb, const float* ba, const float* bx, const float* lam,
                      bf16* HLOC, bf16* PCUM, float* SUMM, int b, int g, int seg, const Ctx& C) {
    constexpr int WA = 0, WX = 34816, XCB = 69632, XCF = 87040, AA = 119808;
    LAS unsigned char* lds = C.lds;
#pragma unroll
    for (int i = 0; i < 4; ++i) { const int idx = C.tid + NT * i, r = idx >> 4, ch = idx & 15;
        *(LAS v4u*)(lds + WA + r * 272 + ch * 16) = *(const v4u*)(waT + g * 16384 + r * 128 + ch * 8); *(LAS v4u*)(lds + WX + r * 272 + ch * 16) = *(const v4u*)(wxT + g * 16384 + r * 128 + ch * 8); }
    const int ct = C.wave & 3, rt = C.wave >> 2, l31 = C.lane & 31, hh = C.lane >> 5, cj = 32 * ct + l31, cg = g * 128 + cj;
    const float bac = ba[cg], bxc = bx[cg], spc = log1pf(fexp(-lam[cg]));
    LAS float* xcf = (LAS float*)(lds + XCF); LAS float* aa = (LAS float*)(lds + AA);
    float hl = 0.f, P = 1.f;
    v4u xr[4][2];
#define RG_PREFETCH(st_) do { int tl_ = C.tid; asm volatile("" : "+v"(tl_)); const int t_ = seg * 512 + (st_) * 64 + (tl_ >> 3); \
        _Pragma("unroll") for (int j_ = 0; j_ < 4; ++j_) { const int tt_ = t_ - 3 + j_; const bf16* rp_ = PROJ + ((size_t)b * SEQ + (tt_ < 0 ? 0 : tt_)) * NIN + g * 128 + 16 * (tl_ & 7); xr[j_][0] = *(const v4u*)rp_; xr[j_][1] = *(const v4u*)(rp_ + 8); } } while (0)
    LAS float* cwl = (LAS float*)(lds + 152576);
    for (int i = C.tid; i < 640; i += NT) cwl[i] = i < 512 ? cw[(i >> 7) * 1024 + g * 128 + (i & 127)] : cb[g * 128 + (i - 512)];
    RG_PREFETCH(0);
    wg_sync();
    for (int st = 0; st < 8; ++st) {
        const int tbase = seg * 512 + st * 64;
        { const int r = C.tid >> 3, cc = C.tid & 7, t = tbase + r, c0 = g * 128 + 16 * cc; float xc[16];
#pragma unroll
          for (int i = 0; i < 4; ++i) { const f32x4 v = *(const LAS f32x4*)(cwl + 512 + 16 * cc + 4 * i); xc[4 * i] = v.x; xc[4 * i + 1] = v.y; xc[4 * i + 2] = v.z; xc[4 * i + 3] = v.w; }
#pragma unroll
          for (int j = 0; j < 4; ++j) { const int tt = t - 3 + j; if (tt < 0) continue;
              const v4u x0 = xr[j][0], x1 = xr[j][1];
              const LAS float* wp = cwl + j * 128 + 16 * cc; const f32x4 w0 = *(const LAS f32x4*)wp, w1 = *(const LAS f32x4*)(wp + 4), w2 = *(const LAS f32x4*)(wp + 8), w3 = *(const LAS f32x4*)(wp + 12);
              xc[0] += w0.x * bflo(x0.x); xc[1] += w0.y * bfhi(x0.x); xc[2] += w0.z * bflo(x0.y); xc[3] += w0.w * bfhi(x0.y); xc[4] += w1.x * bflo(x0.z); xc[5] += w1.y * bfhi(x0.z); xc[6] += w1.z * bflo(x0.w); xc[7] += w1.w * bfhi(x0.w);
              xc[8] += w2.x * bflo(x1.x); xc[9] += w2.y * bfhi(x1.x); xc[10] += w2.z * bflo(x1.y); xc[11] += w2.w * bfhi(x1.y); xc[12] += w3.x * bflo(x1.z); xc[13] += w3.y * bfhi(x1.z); xc[14] += w3.z * bflo(x1.w); xc[15] += w3.w * bfhi(x1.w); }
#pragma unroll
          for (int i = 0; i < 4; ++i) *(LAS f32x4*)(xcf + r * 128 + 16 * cc + 4 * i) = (f32x4){xc[4 * i], xc[4 * i + 1], xc[4 * i + 2], xc[4 * i + 3]};
          v4u p0, p1; p0.x = pk2(xc[0], xc[1]); p0.y = pk2(xc[2], xc[3]); p0.z = pk2(xc[4], xc[5]); p0.w = pk2(xc[6], xc[7]); p1.x = pk2(xc[8], xc[9]); p1.y = pk2(xc[10], xc[11]); p1.z = pk2(xc[12], xc[13]); p1.w = pk2(xc[14], xc[15]);
          *(LAS v4u*)(lds + XCB + r * 272 + cc * 32) = p0; *(LAS v4u*)(lds + XCB + r * 272 + cc * 32 + 16) = p1; }
        wg_sync();
        if (st < 7) RG_PREFETCH(st + 1);
        f32x16 ar, ai; ZERO16(ar); ZERO16(ai);
#pragma unroll
        for (int ks = 0; ks < 8; ++ks) { const int kb = (16 * ks + 8 * hh) * 2;
            const bf16x8 A = *(const LAS bf16x8*)(lds + XCB + (32 * rt + l31) * 272 + kb), Br = *(const LAS bf16x8*)(lds + WA + cj * 272 + kb), Bi = *(const LAS bf16x8*)(lds + WX + cj * 272 + kb);
            ar = mfma32(A, Br, ar); ai = mfma32(A, Bi, ai); }
#pragma unroll
        for (int i = 0; i < 16; ++i) { const int tr = 32 * rt + crow(i, hh); const float xv = xcf[tr * 128 + cj];
            const float r_ = sigmoid_f(ar[i] + bac), ig = sigmoid_f(ai[i] + bxc), av = fexp(-8.0f * r_ * spc), mult = __builtin_amdgcn_sqrtf(fmaxf(1.0f - av * av, 0.f));
            xcf[tr * 128 + cj] = mult * ig * xv; aa[tr * 128 + cj] = av; }
        wg_sync();
        if (C.tid < 128) {
#pragma unroll 2
            for (int r0 = 0; r0 < 64; r0 += 8) { float av[8], uv[8];
#pragma unroll
                for (int i = 0; i < 8; ++i) { av[i] = aa[(r0 + i) * 128 + C.tid]; uv[i] = xcf[(r0 + i) * 128 + C.tid]; }
#pragma unroll
                for (int i = 0; i < 8; ++i) { hl = av[i] * hl + uv[i]; P *= av[i]; uv[i] = hl; av[i] = P; }
#pragma unroll
                for (int i = 0; i < 8; ++i) { xcf[(r0 + i) * 128 + C.tid] = uv[i]; aa[(r0 + i) * 128 + C.tid] = av[i]; } } }
        wg_sync();
#pragma unroll
        for (int i = 0; i < 4; ++i) { const int idx = C.tid + NT * i, r = idx >> 5, c4 = (idx & 31) * 4; const size_t o = ((size_t)b * SEQ + tbase + r) * 1024 + g * 128 + c4;
            const f32x4 hv = *(const LAS f32x4*)(xcf + r * 128 + c4), pv = *(const LAS f32x4*)(aa + r * 128 + c4); v2u ho, po; ho.x = pk2(hv.x, hv.y); ho.y = pk2(hv.z, hv.w); po.x = pk2(pv.x, pv.y); po.y = pk2(pv.z, pv.w);
            *(v2u*)(HLOC + o) = ho; *(v2u*)(PCUM + o) = po; }
        wg_sync();
    }
#undef RG_PREFETCH
    if (C.tid < 128) { float* sp = SUMM + (size_t)((b * 8 + g) * 16 + seg) * 256; sp[C.tid] = P; sp[128 + C.tid] = hl; }
}
template <bool OUT8>
DI void rg_step2_unit(const bf16* PROJ, const bf16* HLOC, const bf16* PCUM, const float* SUMM, bf16* YCAT, int b, int g, int seg, const Ctx& C) {
    LAS float* carry = (LAS float*)C.lds;
    if (C.tid < 128) { float pa[15], ha[15];
#pragma unroll
        for (int s = 0; s < 15; ++s) { const float* sp = SUMM + (size_t)((b * 8 + g) * 16 + (s < seg ? s : 0)) * 256; pa[s] = sp[C.tid]; ha[s] = sp[128 + C.tid]; }
        float hc = 0.f;
#pragma unroll
        for (int s = 0; s < 15; ++s) hc = s < seg ? pa[s] * hc + ha[s] : hc;
        carry[C.tid] = hc; }
    wg_sync();
#pragma unroll 1
    for (int i0 = 0; i0 < 16; i0 += 8) { v4u hb[8], pb[8], gr[8];
#pragma unroll
        for (int k = 0; k < 8; ++k) { const int it = C.tid + NT * (i0 + k), r = it >> 4, c8 = (it & 15) * 8; const size_t mrow = (size_t)b * SEQ + seg * 512 + r, idx = mrow * 1024 + g * 128 + c8;
            hb[k] = *(const v4u*)(HLOC + idx); pb[k] = *(const v4u*)(PCUM + idx); gr[k] = *(const v4u*)(PROJ + mrow * NIN + 1024 + g * 128 + c8); }
#pragma unroll
        for (int k = 0; k < 8; ++k) { const int it = C.tid + NT * (i0 + k), r = it >> 4, c8 = (it & 15) * 8; const size_t mrow = (size_t)b * SEQ + seg * 512 + r;
            const f32x4 cy0 = *(const LAS f32x4*)(carry + c8), cy1 = *(const LAS f32x4*)(carry + c8 + 4); const v4u h_ = hb[k], p_ = pb[k], g_ = gr[k];
            const float y0 = (bflo(h_.x) + bflo(p_.x) * cy0.x) * gelu_tanh(bflo(g_.x)), y1 = (bfhi(h_.x) + bfhi(p_.x) * cy0.y) * gelu_tanh(bfhi(g_.x)), y2 = (bflo(h_.y) + bflo(p_.y) * cy0.z) * gelu_tanh(bflo(g_.y)), y3 = (bfhi(h_.y) + bfhi(p_.y) * cy0.w) * gelu_tanh(bfhi(g_.y));
            const float y4 = (bflo(h_.z) + bflo(p_.z) * cy1.x) * gelu_tanh(bflo(g_.z)), y5 = (bfhi(h_.z) + bfhi(p_.z) * cy1.y) * gelu_tanh(bfhi(g_.z)), y6 = (bflo(h_.w) + bflo(p_.w) * cy1.z) * gelu_tanh(bflo(g_.w)), y7 = (bfhi(h_.w) + bfhi(p_.w) * cy1.w) * gelu_tanh(bfhi(g_.w));
            if (OUT8) { v2u o; o.x = pg8::cvt4_fp8(y0, y1, y2, y3); o.y = pg8::cvt4_fp8(y4, y5, y6, y7); *(v2u*)((unsigned char*)YCAT + mrow * D + g * 128 + c8) = o; }
            else { v4u o; o.x = pk2(y0, y1); o.y = pk2(y2, y3); o.z = pk2(y4, y5); o.w = pk2(y6, y7); *(v4u*)(YCAT + mrow * D + g * 128 + c8) = o; } } }
    wg_sync();
}
DI void mlstm_scalars(const float* GATES, LAS float* sb, int mbase, int hh, const Ctx& C) {
    float lf = 0.f, ip = 0.f;
    if (C.tid < 256) { ip = GATES[(size_t)(mbase + C.tid) * 8 + hh]; lf = log_sigmoid_f(GATES[(size_t)(mbase + C.tid) * 8 + 4 + hh]); }
    float v = lf;
#pragma unroll
    for (int o = 1; o < 64; o <<= 1) { const float n = __shfl_up(v, o); if (C.lane >= o) v += n; }
    LAS float* wt = sb + 768;
    if (C.tid < 256 && C.lane == 63) wt[C.wave] = v;
    wg_sync();
    float e = -INFINITY;
    if (C.tid < 256) { float pre = 0.f; for (int w = 0; w < C.wave; ++w) pre += wt[w]; v += pre; sb[C.tid] = v; e = ip - v; sb[256 + C.tid] = e; }
    float cm = e;
#pragma unroll
    for (int o = 1; o < 64; o <<= 1) { const float n = __shfl_up(cm, o); if (C.lane >= o) cm = fmaxf(cm, n); }
    if (C.tid < 256 && C.lane == 63) wt[8 + C.wave] = cm;
    wg_sync();
    if (C.tid < 256) { float pre = -INFINITY; for (int w = 0; w < C.wave; ++w) pre = fmaxf(pre, wt[8 + w]); sb[512 + C.tid] = fmaxf(cm, pre); }
    wg_sync();
}
DI void mlstm_x1_unit(const bf16* PROJ, const float* GATES, bf16* USTATE, float* NST, float* CH, int b, int hh, int c, const Ctx& C) {
    constexpr int KS = 0, VS = 33792, SB = 67584, WV = 71680, PITCH = 528;
    LAS unsigned char* lds = C.lds; LAS float* sb = (LAS float*)(lds + SB); LAS float* wv = (LAS float*)(lds + WV);
    const int mbase = b * SEQ + c * 256, chain = b * 4 + hh;
    mlstm_scalars(GATES, sb, mbase, hh, C);
    const float gl = sb[767];
    if (C.tid < 256) wv[C.tid] = fexp(sb[256 + C.tid] - gl);
    if (C.tid == 0) { CH[(chain * 32 + c) * 2] = sb[255]; CH[(chain * 32 + c) * 2 + 1] = gl; }
    wg_sync();
    const int l31 = C.lane & 31, h2 = C.lane >> 5, blk = (C.lane >> 4) & 1, q = (C.lane & 15) >> 2, p = C.lane & 3;
    f32x16 acc[8];
#pragma unroll
    for (int i = 0; i < 8; ++i) ZERO16(acc[i]);
    float nacc = 0.f;
    for (int sbk = 0; sbk < 4; ++sbk) {
#pragma unroll
        for (int i = 0; i < 4; ++i) { const int idx = C.tid + NT * i, r = idx >> 5, ch = idx & 31; const bf16* rp = PROJ + (size_t)(mbase + sbk * 64 + r) * NIN + 256 * hh + 8 * ch;
            *(LAS v4u*)(lds + KS + r * PITCH + ch * 16) = *(const v4u*)(rp + 3072);
            const v4u vv = *(const v4u*)(rp + 4096); const float w = wv[sbk * 64 + r]; v4u o;
            o.x = pk2(bflo(vv.x) * w, bfhi(vv.x) * w); o.y = pk2(bflo(vv.y) * w, bfhi(vv.y) * w); o.z = pk2(bflo(vv.z) * w, bfhi(vv.z) * w); o.w = pk2(bflo(vv.w) * w, bfhi(vv.w) * w);
            *(LAS v4u*)(lds + VS + r * PITCH + ch * 16) = o; }
        wg_sync();
        if (C.tid < 256) {
#pragma unroll 8
            for (int r = 0; r < 64; ++r) nacc += wv[sbk * 64 + r] * bf2f(*(const LAS bf16*)(lds + KS + r * PITCH + C.tid * 2)); }
#pragma unroll
        for (int ks = 0; ks < 4; ++ks) { const int r0 = 16 * ks + 8 * h2;
            const bf16x8 A = tr_frag(lds + KS, PITCH, r0, r0 + 4, (32 * C.wave + 16 * blk + 4 * p) * 2, q);
#pragma unroll
            for (int et = 0; et < 8; ++et) { const bf16x8 B = tr_frag(lds + VS, PITCH, r0, r0 + 4, (32 * et + 16 * blk + 4 * p) * 2, q); acc[et] = mfma32(A, B, acc[et]); } }
        wg_sync();
    }
    bf16* Up = USTATE + (size_t)(chain * 32 + c) * 65536;
#pragma unroll
    for (int et = 0; et < 8; ++et)
#pragma unroll
        for (int i = 0; i < 16; i += 2) { float a0 = acc[et][i], a1 = acc[et][i + 1]; asm volatile("" : "+v"(a0), "+v"(a1));
            const float mine = (C.lane & 1) ? a1 : a0, give = (C.lane & 1) ? a0 : a1; const float got = __shfl_xor(give, 1);
            const int row = 32 * C.wave + crow(i + (C.lane & 1), h2), col = 32 * et + (l31 & ~1);
            *(unsigned*)(Up + (size_t)row * 256 + col) = (C.lane & 1) ? pk2(got, mine) : pk2(mine, got); }
    if (C.tid < 256) NST[(size_t)(chain * 32 + c) * 256 + C.tid] = nacc;
}
DI void mlstm_x2(bf16* USTATE, float* NST, const float* CH, float* CHS, const Ctx& C) {
    for (int w = C.bid * NT + C.tid; w < 8 * 8192 + 8 * 64; w += C.G * NT) {
        const bool isn = w >= 8 * 8192; const int ww = isn ? w - 8 * 8192 : w; const int chain = isn ? ww >> 6 : ww >> 13;
        float Boff = 0.f, R = 0.f;
        if (isn) { float* base = NST + (size_t)chain * 32 * 256 + (ww & 63) * 4; f32x4 st = {0.f, 0.f, 0.f, 0.f};
#pragma unroll 4
            for (int c = 0; c < 32; ++c) { const float Bsum = CH[(chain * 32 + c) * 2], gl = CH[(chain * 32 + c) * 2 + 1]; const float Rn = fmaxf(R, gl - Boff), dec = fexp(R - Rn), wu = fexp(gl - Boff - Rn);
                f32x4* pp = (f32x4*)(base + c * 256); const f32x4 u = *pp; *pp = st; st = dec * st + wu * u; Boff += Bsum; R = Rn; } }
        else { bf16* base = USTATE + (size_t)chain * 32 * 65536 + (ww & 8191) * 8; float st[8];
#pragma unroll
            for (int i = 0; i < 8; ++i) st[i] = 0.f;
#pragma unroll 4
            for (int c = 0; c < 32; ++c) { const float Bsum = CH[(chain * 32 + c) * 2], gl = CH[(chain * 32 + c) * 2 + 1]; const float Rn = fmaxf(R, gl - Boff), dec = fexp(R - Rn), wu = fexp(gl - Boff - Rn);
                v4u* pp = (v4u*)(base + (size_t)c * 65536); const v4u u = *pp; v4u o; o.x = pk2(st[0], st[1]); o.y = pk2(st[2], st[3]); o.z = pk2(st[4], st[5]); o.w = pk2(st[6], st[7]); *pp = o;
                st[0] = dec * st[0] + wu * bflo(u.x); st[1] = dec * st[1] + wu * bfhi(u.x); st[2] = dec * st[2] + wu * bflo(u.y); st[3] = dec * st[3] + wu * bfhi(u.y);
                st[4] = dec * st[4] + wu * bflo(u.z); st[5] = dec * st[5] + wu * bfhi(u.z); st[6] = dec * st[6] + wu * bflo(u.w); st[7] = dec * st[7] + wu * bfhi(u.w);
                if ((ww & 8191) == 0) { CHS[(chain * 32 + c) * 2] = Boff; CHS[(chain * 32 + c) * 2 + 1] = R; }
                Boff += Bsum; R = Rn; } }
    }
}
DI f32x4 mfma16(bf16x8 a, bf16x8 b, f32x4 c) { return __builtin_amdgcn_mfma_f32_16x16x32_bf16(a, b, c, 0, 0, 0); }
template <bool OUT8>
DI void mlstm_x3b_unit(const bf16* PROJ, const float* GATES, const bf16* USTATE, const float* NST, const float* CHS, bf16* YCAT, int b, int hh, int c, const Ctx& C) {
    constexpr int CS = 0, CPITCH = 272, KS = 69632, KPITCH = 528, VS = 103424, VPITCH = 272, SB = 120832, AR = 124928;
    LAS unsigned char* lds = C.lds; LAS float* sb = (LAS float*)(lds + SB); LAS float* esb = (LAS float*)(lds + AR); LAS float* Gq = esb + 256; LAS float* wint = esb + 512; LAS float* mex = esb + 768; LAS float* nh = esb + 1024; LAS float* dqa = esb + 1280;
    const int mbase = b * SEQ + c * 256, chain = b * 4 + hh;
    mlstm_scalars(GATES, sb, mbase, hh, C);
    const float Boff = CHS[(chain * 32 + c) * 2], R = CHS[(chain * 32 + c) * 2 + 1];
    if (C.tid < 256) { const float e = sb[256 + C.tid], cm = sb[512 + C.tid], bc = sb[C.tid], G = fmaxf(R, cm - Boff);
        esb[C.tid] = e - Boff; Gq[C.tid] = G; wint[C.tid] = fexp(R - G); mex[C.tid] = fexp(-(Boff + bc + G)); nh[C.tid] = NST[(size_t)(chain * 32 + c) * 256 + C.tid]; }
    wg_sync();
    const int l15 = C.lane & 15, g = C.lane >> 4, q = l15 >> 2, p = l15 & 3;
    int qt[2]; qt[0] = C.wave; qt[1] = 15 - C.wave;
    bf16x8 Q[2][8];
#pragma unroll
    for (int T = 0; T < 2; ++T) { const int t = 16 * qt[T] + l15; const size_t m = (size_t)mbase + t;
#pragma unroll
        for (int ks = 0; ks < 8; ++ks) Q[T][ks] = *(const bf16x8*)(PROJ + m * NIN + 2048 + 256 * hh + 32 * ks + 8 * g);
        float d = 0.f;
#pragma unroll
        for (int ks = 0; ks < 8; ++ks) { const f32x4 n0 = *(const LAS f32x4*)(nh + 32 * ks + 8 * g), n1 = *(const LAS f32x4*)(nh + 32 * ks + 8 * g + 4); const v4u qw = __builtin_bit_cast(v4u, Q[T][ks]);
            d += (bflo(qw.x) * n0.x + bfhi(qw.x) * n0.y) + (bflo(qw.y) * n0.z + bfhi(qw.y) * n0.w) + (bflo(qw.z) * n1.x + bfhi(qw.z) * n1.y) + (bflo(qw.w) * n1.z + bfhi(qw.w) * n1.w);
            __builtin_amdgcn_sched_barrier(0); }
        d += __shfl_xor(d, 16); d += __shfl_xor(d, 32); if (g == 0) dqa[t] = d; }
    for (int eh = 0; eh < 2; ++eh) {
        { int tl = C.tid; asm volatile("" : "+v"(tl)); const bf16* cp = USTATE + ((size_t)(chain * 32 + c) * 256 + (tl >> 4)) * 256 + 128 * eh + 8 * (tl & 15); LAS unsigned char* cd = lds + CS + (tl >> 4) * CPITCH + (tl & 15) * 16;
#pragma unroll
          for (int i0 = 0; i0 < 8; i0 += 4) { v4u cc[4];
#pragma unroll
              for (int i = 0; i < 4; ++i) cc[i] = *(const v4u*)(cp + (size_t)(i0 + i) * 32 * 256);
#pragma unroll
              for (int i = 0; i < 4; ++i) *(LAS v4u*)(cd + (i0 + i) * 32 * CPITCH) = cc[i]; } }
        v4u pk[4], pv[2];
#define X3B_PREFETCH(kb_) do { int tl_ = C.tid; asm volatile("" : "+v"(tl_)); const bf16* kp_ = PROJ + (size_t)(mbase + (kb_) * 64 + (tl_ >> 5)) * NIN + 3072 + 256 * hh + 8 * (tl_ & 31); \
        _Pragma("unroll") for (int i_ = 0; i_ < 4; ++i_) pk[i_] = *(const v4u*)(kp_ + (size_t)i_ * 16 * NIN); \
        const bf16* vp_ = PROJ + (size_t)(mbase + (kb_) * 64 + (tl_ >> 4)) * NIN + 4096 + 256 * hh + 128 * eh + 8 * (tl_ & 15); \
        _Pragma("unroll") for (int i_ = 0; i_ < 2; ++i_) pv[i_] = *(const v4u*)(vp_ + (size_t)i_ * 32 * NIN); } while (0)
        X3B_PREFETCH(0);
        wg_sync();
        f32x4 acc[2][8]; float dsum[2];
#pragma unroll
        for (int T = 0; T < 2; ++T) { dsum[T] = 0.f;
#pragma unroll
            for (int et = 0; et < 8; ++et) acc[T][et] = (f32x4){0.f, 0.f, 0.f, 0.f};
#pragma unroll
            for (int ks = 0; ks < 8; ++ks) { const int r0 = 32 * ks + 8 * g;
#pragma unroll
                for (int et = 0; et < 8; ++et) { const bf16x8 A = tr_frag(lds + CS, CPITCH, r0, r0 + 4, (16 * et + 4 * p) * 2, q); acc[T][et] = mfma16(A, Q[T][ks], acc[T][et]); }
                __builtin_amdgcn_sched_barrier(0); }
            { const float wiT = wint[16 * qt[T] + l15];
#pragma unroll
              for (int et = 0; et < 8; ++et) acc[T][et] = acc[T][et] * wiT; } }
        for (int kb = 0; kb < 4; ++kb) {
            wg_sync();
            { int tl = C.tid; asm volatile("" : "+v"(tl)); LAS unsigned char* kd = lds + KS + (tl >> 5) * KPITCH + (tl & 31) * 16; LAS unsigned char* vd = lds + VS + (tl >> 4) * VPITCH + (tl & 15) * 16;
#pragma unroll
              for (int i = 0; i < 4; ++i) *(LAS v4u*)(kd + i * 16 * KPITCH) = pk[i];
#pragma unroll
              for (int i = 0; i < 2; ++i) *(LAS v4u*)(vd + i * 32 * VPITCH) = pv[i]; }
            wg_sync();
            if (kb < 3) X3B_PREFETCH(kb + 1);
#pragma unroll
            for (int T = 0; T < 2; ++T) {
                if (4 * kb > qt[T]) continue;
                const int tq = 16 * qt[T] + l15; const float GtT = Gq[tq];
#pragma unroll
                for (int pp = 0; pp < 2; ++pp) { const int kta = 4 * kb + 2 * pp; if (kta > qt[T]) continue;
                    f32x4 Sa = {0.f, 0.f, 0.f, 0.f}, Sb = {0.f, 0.f, 0.f, 0.f}; const bool hasb = kta + 1 <= qt[T];
#pragma unroll
                    for (int ks = 0; ks < 8; ++ks) { const bf16x8 A = *(const LAS bf16x8*)(lds + KS + (32 * pp + l15) * KPITCH + (32 * ks + 8 * g) * 2); Sa = mfma16(A, Q[T][ks], Sa); }
                    if (hasb) {
#pragma unroll
                        for (int ks = 0; ks < 8; ++ks) { const bf16x8 A = *(const LAS bf16x8*)(lds + KS + (32 * pp + 16 + l15) * KPITCH + (32 * ks + 8 * g) * 2); Sb = mfma16(A, Q[T][ks], Sb); } }
#pragma unroll
                    for (int i = 0; i < 4; ++i) { const int sa_ = 16 * kta + 4 * g + i, sb_ = sa_ + 16;
                        const float wa = (sa_ <= tq) ? fexp(esb[sa_] - GtT) : 0.f, wb = (hasb && sb_ <= tq) ? fexp(esb[sb_] - GtT) : 0.f;
                        Sa[i] *= wa; Sb[i] *= wb; dsum[T] += Sa[i] + Sb[i]; }
                    v4u pw; pw.x = pk2(Sa[0], Sa[1]); pw.y = pk2(Sa[2], Sa[3]); pw.z = pk2(Sb[0], Sb[1]); pw.w = pk2(Sb[2], Sb[3]);
                    const bf16x8 Pf = __builtin_bit_cast(bf16x8, pw); const int r0 = 32 * pp + 4 * g;
#pragma unroll
                    for (int et = 0; et < 8; ++et) { const bf16x8 A = tr_frag(lds + VS, VPITCH, r0, r0 + 16, (16 * et + 4 * p) * 2, q); acc[T][et] = mfma16(A, Pf, acc[T][et]); }
                    __builtin_amdgcn_sched_barrier(0); }
            }
        }
#undef X3B_PREFETCH
#pragma unroll
        for (int T = 0; T < 2; ++T) { const int t = 16 * qt[T] + l15; const size_t m = (size_t)mbase + t;
            float ds = dsum[T]; ds += __shfl_xor(ds, 16); ds += __shfl_xor(ds, 32);
            const float den = (wint[t] * dqa[t] + ds) * 0.0625f, inv = 0.0625f / fmaxf(fabsf(den), mex[t]);
            v2u ogv[8];
#pragma unroll
            for (int et = 0; et < 8; ++et) ogv[et] = *(const v2u*)(PROJ + m * NIN + 5120 + 256 * hh + 128 * eh + 16 * et + 4 * g);
#pragma unroll
            for (int et = 0; et < 8; ++et) { const int e0 = 128 * eh + 16 * et + 4 * g; const v2u og = ogv[et];
                const float y0 = acc[T][et][0] * inv * sigmoid_f(bflo(og.x)), y1 = acc[T][et][1] * inv * sigmoid_f(bfhi(og.x)), y2 = acc[T][et][2] * inv * sigmoid_f(bflo(og.y)), y3 = acc[T][et][3] * inv * sigmoid_f(bfhi(og.y));
                if (OUT8) *(unsigned*)((unsigned char*)YCAT + m * D + 1024 + 256 * hh + e0) = pg8::cvt4_fp8(y0, y1, y2, y3);
                else { v2u o; o.x = pk2(y0, y1); o.y = pk2(y2, y3); *(v2u*)(YCAT + m * D + 1024 + 256 * hh + e0) = o; } } }
        wg_sync();
    }
}

#define GEMM_PHASE(EpiT, Eobj, Aptr, Bptr, NN, KK) do { pg8::Gemm g_{(const pg8::bf16_t*)(Aptr), (const pg8::bf16_t*)(Bptr), M, (NN), (KK)}; pg8::StaticOrder S_; S_.init(M, (NN), C0.G, C0.bid); \
    pg8::gemm_phase<EpiT, pg8::StaticOrder, true, true>(C0.lds, g_, S_, Eobj); } while (0)
#define GEMM_PHASEI8(EpiT, Eobj, Aptr, Bptr, NN, KBYTES) do { pg8::Gemm g_{(const pg8::bf16_t*)(Aptr), (const pg8::bf16_t*)(Bptr), M, (NN), (KBYTES) / 2}; pg8::StaticOrder S_; S_.init(M, (NN), C0.G, C0.bid); \
    pg8::gemm_phase<EpiT, pg8::StaticOrder, true, true, false, true>(C0.lds, g_, S_, Eobj); } while (0)
#define GEMM_PHASE8(EpiT, Eobj, Aptr, Bptr, NN, KBYTES) do { pg8::Gemm g_{(const pg8::bf16_t*)(Aptr), (const pg8::bf16_t*)(Bptr), M, (NN), (KBYTES) / 2}; pg8::StaticOrder S_; S_.init(M, (NN), C0.G, C0.bid); \
    pg8::gemm_phase<EpiT, pg8::StaticOrder, true, true, true>(C0.lds, g_, S_, Eobj); } while (0)
__global__ void __launch_bounds__(NT, 2) fwd(Args a) {
    extern __shared__ __attribute__((aligned(16))) unsigned char lds_raw[];
    Ctx C0; C0.lds = (LAS unsigned char*)lds_raw; C0.tid = threadIdx.x; C0.lane = C0.tid & 63; C0.wave = __builtin_amdgcn_readfirstlane(C0.tid >> 6); C0.G = gridDim.x; C0.bid = blockIdx.x;
    C0.gw = C0.bid * NWAVES + C0.wave; C0.ngw = C0.G * NWAVES;
#define PH(...) do { const Ctx C = fresh(C0); __VA_ARGS__; } while (0)
    volatile LAS unsigned* MISC = (volatile LAS unsigned*)(C0.lds + MISC_OFF);
    if (C0.tid < 128) MISC[C0.tid] = 0u;
    __syncthreads();
    unsigned char* ws = a.ws; unsigned* ctl = (unsigned*)(ws + WS_CTL);
    XcdBarrier bar = xcd_barrier_post(ctl + CW_BAR, MISC + 8);
    float* MOD = (float*)(ws + WS_SMALL + SM_MOD); bf16* XN = (bf16*)(ws + WS_XN); bf16* PROJ = (bf16*)(ws + WS_PROJ); bf16* ACT = (bf16*)(ws + WS_PROJ); bf16* YCAT = (bf16*)(ws + WS_YCAT);
    float* GATES = (float*)(ws + WS_SMALL + SM_GATES); float* SUMM = (float*)(ws + WS_SMALL + SM_SUMM); float* CH = (float*)(ws + WS_SMALL + SM_CH); float* CHS = (float*)(ws + WS_SMALL + SM_CHS); float* NST = (float*)(ws + WS_SMALL + SM_NST);
    bf16* HLOC = (bf16*)(ws + WS_XN); bf16* PCUM = (bf16*)(ws + WS_S1); bf16* USTATE = (bf16*)(ws + WS_S2);
    const bf16* waT = (const bf16*)(ws + WS_SMALL + SM_WAT); const bf16* wxT = (const bf16*)(ws + WS_SMALL + SM_WXT);
    bf16* X = (bf16*)(ws + WS_XB); float* SA = (float*)(ws + WS_SMALL + SM_SA);

    PH(p0_prologue(a, C)); xcd_barrier(bar);
    { const float* mod = MOD; unsigned char* wl = ws + WS_W;
#if INPROJ0_I8 == 2
      PH(norm_phase<false, 3, false>(a.in[0], a.in[4], mod + 0 * D, mod + 1 * D, XN, nullptr, nullptr, nullptr, SA + 2 * M, C, (unsigned char*)YCAT, X)); xcd_barrier(bar);
      { typedef pg8::EpiBf16P<true> EpiIn8; EpiIn8 E{(pg8::bf16_t*)PROJ, NIN, (float*)(ws + WS_CTL + CTL_KACC), SA + 2 * M, 1.0f / WIN_QW}; GEMM_PHASEI8(EpiIn8, E, YCAT, wl + LW_IN, 3072, D); }
      { typedef pg8::EpiBf16P<false> EpiIn; EpiIn E{(pg8::bf16_t*)PROJ + 3072, NIN, nullptr, nullptr, 1.0f}; GEMM_PHASE(EpiIn, E, XN, (bf16*)(wl + LW_IN) + (size_t)3072 * D, 3072, D); } xcd_barrier(bar);
#elif INPROJ0_I8
      PH(norm_phase<false, 2, false>(a.in[0], a.in[4], mod + 0 * D, mod + 1 * D, XN, nullptr, nullptr, nullptr, SA + 2 * M, C)); xcd_barrier(bar);
      { typedef pg8::EpiBf16P<true> EpiIn; EpiIn E{(pg8::bf16_t*)PROJ, NIN, (float*)(ws + WS_CTL + CTL_KACC), SA + 2 * M, 1.0f / WIN_QW}; GEMM_PHASEI8(EpiIn, E, XN, wl + LW_IN, NIN, D); } xcd_barrier(bar);
#else
      PH(norm_phase<false, 0, false>(a.in[0], a.in[4], mod + 0 * D, mod + 1 * D, XN, nullptr, nullptr, nullptr, nullptr, C)); xcd_barrier(bar);
      { typedef pg8::EpiBf16P<false> EpiIn; EpiIn E{(pg8::bf16_t*)PROJ, NIN, (float*)(ws + WS_CTL + CTL_KACC), nullptr, 1.0f}; GEMM_PHASE(EpiIn, E, XN, wl + LW_IN, NIN, D); } xcd_barrier(bar);
#endif
      PH(conv_phase(PROJ, a.in[10], YCAT, C));
      { unsigned* MCNT = (unsigned*)(ws + WS_CTL + CTL_MCNT); unsigned* MLIST = (unsigned*)(ws + WS_XN + 8 * MiB); float* MML = (float*)(ws + WS_XN); bf16* MPART = (bf16*)(ws + WS_S1);
        PH(for (int u = C.bid; u < 512; u += C.G) { const int kk = (u >> 4) & 15; const int j = (u < 256) ? 31 - kk : kk; const int bh = u & 15; moba_gate_unit(PROJ, (const float*)(ws + WS_CTL + CTL_KACC), MCNT, MLIST, bh >> 3, bh & 7, j, C); });
        xcd_barrier(bar);
        PH(moba_work_phase(PROJ, MCNT, MLIST, (unsigned*)(ws + WS_CTL + CTL_MQ), MPART, MML, C));
        xcd_barrier(bar);
        PH(moba_merge_phase(MPART, MML, YCAT, C)); }
      xcd_barrier(bar);
      { typedef pg8::EpiResGate<false> EpiR0; EpiR0 E{X, (pg8::bf16_t*)X, D, mod + 2 * D, MODW, 1.0f}; GEMM_PHASE(EpiR0, E, YCAT, wl + LW_OUT, D, D); } xcd_barrier(bar);
      PH(norm_phase<false, 2, true>(X, a.in[5], mod + 3 * D, mod + 4 * D, XN, nullptr, nullptr, nullptr, SA, C)); xcd_barrier(bar);
#if FFN0_DOWN_FP8
      { typedef pg8::EpiSwiGLU<true, true> EpiUp; EpiUp E{(void*)ACT, FF, 1.0f / W13_QW, SA}; GEMM_PHASEI8(EpiUp, E, XN, wl + LW_13, N13, D); } xcd_barrier(bar);
      { typedef pg8::EpiResGate<false> EpiR; EpiR E{X, (pg8::bf16_t*)X, D, mod + 5 * D, MODW, 1.0f / W2_SCALE}; GEMM_PHASE8(EpiR, E, ACT, wl + LW_2, D, FF); } xcd_barrier(bar);
#else
      { typedef pg8::EpiSwiGLU<false, true> EpiUp; EpiUp E{(void*)ACT, FF, 1.0f / W13_QW, SA}; GEMM_PHASEI8(EpiUp, E, XN, wl + LW_13, N13, D); } xcd_barrier(bar);
      { typedef pg8::EpiResGate<false> EpiR; EpiR E{X, (pg8::bf16_t*)X, D, mod + 5 * D, MODW, 1.0f}; GEMM_PHASE(EpiR, E, ACT, wl + LW_2, D, FF); } xcd_barrier(bar);
#endif
    }
    { const float* mod = MOD + 2 * MODW; unsigned char* wl = ws + WS_W + LW_SIZE;
#if INPROJ1_I8
      PH(norm_phase<true, 3, true>(X, a.in[4] + D, mod + 0 * D, mod + 1 * D, XN, a.in[12], a.in[13], GATES, SA + 3 * M, C, (unsigned char*)YCAT)); xcd_barrier(bar);
      { typedef pg8::EpiBf16P<true> EpiIn8; EpiIn8 E{(pg8::bf16_t*)PROJ, NIN, nullptr, SA + 3 * M, 1.0f / WIN_QW, 8, 8}; GEMM_PHASEI8(EpiIn8, E, YCAT, wl + LW_IN, 4096, D); }
      { typedef pg8::EpiBf16P<false> EpiIn; EpiIn E{(pg8::bf16_t*)PROJ + 2048, NIN, nullptr, nullptr, 1.0f}; GEMM_PHASE(EpiIn, E, XN, (bf16*)(wl + LW_IN) + (size_t)2048 * D, 2048, D); } xcd_barrier(bar);
#else
      PH(norm_phase<true, 0, true>(X, a.in[4] + D, mod + 0 * D, mod + 1 * D, XN, a.in[12], a.in[13], GATES, nullptr, C)); xcd_barrier(bar);
      { typedef pg8::EpiBf16P<false> EpiIn; EpiIn E{(pg8::bf16_t*)PROJ, NIN, nullptr, nullptr, 1.0f}; GEMM_PHASE(EpiIn, E, XN, wl + LW_IN, NIN, D); } xcd_barrier(bar);
#endif
      PH(for (int u = C.bid; u < 256; u += C.G) { rg_step1_unit(PROJ, waT, wxT, a.in[14], a.in[15], a.in[17], a.in[19], a.in[20], HLOC, PCUM, SUMM, u >> 7, (u >> 4) & 7, u & 15, C); wg_sync(); });
      PH(for (int u = C.bid; u < 256; u += C.G) { mlstm_x1_unit(PROJ, GATES, USTATE, NST, CH, u >> 7, (u >> 5) & 3, u & 31, C); wg_sync(); });
      xcd_barrier(bar);
      PH(mlstm_x2(USTATE, NST, CH, CHS, C)); xcd_barrier(bar);
      PH(for (int u = C.bid; u < 256; u += C.G) rg_step2_unit<OUT1_FP8>(PROJ, HLOC, PCUM, SUMM, YCAT, u >> 7, (u >> 4) & 7, u & 15, C));
      PH(for (int u = C.bid; u < 256; u += C.G) mlstm_x3b_unit<OUT1_FP8>(PROJ, GATES, USTATE, NST, CHS, YCAT, u >> 7, (u >> 5) & 3, u & 31, C));
      xcd_barrier(bar);
#if OUT1_FP8
      { typedef pg8::EpiResGate<false> EpiR; EpiR E{X, (pg8::bf16_t*)X, D, mod + 2 * D, MODW, 1.0f / WOUT_SCALE}; GEMM_PHASE8(EpiR, E, YCAT, wl + LW_OUT, D, D); } xcd_barrier(bar);
#else
      { typedef pg8::EpiResGate<false> EpiR; EpiR E{X, (pg8::bf16_t*)X, D, mod + 2 * D, MODW, 1.0f}; GEMM_PHASE(EpiR, E, YCAT, wl + LW_OUT, D, D); } xcd_barrier(bar);
#endif
#if UP1_FP8
      PH(norm_phase<false, 1, true>(X, a.in[5] + D, mod + 3 * D, mod + 4 * D, XN, nullptr, nullptr, nullptr, nullptr, C)); xcd_barrier(bar);
      { typedef pg8::EpiSwiGLU<true, false> EpiUp8; EpiUp8 E{(void*)ACT, FF, 1.0f / 64.0f, nullptr}; GEMM_PHASE8(EpiUp8, E, XN, wl + LW_13, N13, D); } xcd_barrier(bar);
#else
      PH(norm_phase<false, 2, true>(X, a.in[5] + D, mod + 3 * D, mod + 4 * D, XN, nullptr, nullptr, nullptr, SA + M, C)); xcd_barrier(bar);
      { typedef pg8::EpiSwiGLU<true, true> EpiUp; EpiUp E{(void*)ACT, FF, 1.0f / W13_QW, SA + M}; GEMM_PHASEI8(EpiUp, E, XN, wl + LW_13, N13, D); } xcd_barrier(bar);
#endif
      { typedef pg8::EpiResGate<false> EpiR; EpiR E{X, (pg8::bf16_t*)X, D, mod + 5 * D, MODW, 1.0f / W2_SCALE}; GEMM_PHASE8(EpiR, E, ACT, wl + LW_2, D, FF); } xcd_barrier(bar);
    }
    PH(final_norm(X, a.out, a.in[22], C));
}

extern "C" void kernel_launch(void* const* d_in, const int* in_sizes, int n_in, void* d_out, int out_size, void* d_ws, size_t ws_size, hipStream_t stream) {
    static int grid = 0;
    if (grid == 0) {
        if (n_in != 23 || out_size != M * D || ws_size < WS_END) { fprintf(stderr, "kernel_launch: unexpected shapes (n_in %d out %d ws %zu)\n", n_in, out_size, ws_size); grid = -1; return; }
        int dev = 0, cus = 0, per_cu = 0;
        if (hipGetDevice(&dev) != hipSuccess || hipDeviceGetAttribute(&cus, hipDeviceAttributeMultiprocessorCount, dev) != hipSuccess) { grid = -1; return; }
        if (hipFuncSetAttribute((const void*)fwd, hipFuncAttributeMaxDynamicSharedMemorySize, LDS_BYTES) != hipSuccess) { fprintf(stderr, "kernel_launch: hipFuncSetAttribute failed\n"); grid = -1; return; }
        if (hipOccupancyMaxActiveBlocksPerMultiprocessor(&per_cu, (const void*)fwd, NT, LDS_BYTES) != hipSuccess || per_cu < 1) { fprintf(stderr, "kernel_launch: occupancy query says %d\n", per_cu); (void)hipGetLastError(); grid = -1; return; }
        grid = cus;
    }
    if (grid < 0) return;
    if (hipMemsetAsync((char*)d_ws + WS_CTL, 0, CTL_ZERO_BYTES, stream) != hipSuccess) return;
    Args a{};
    for (int i = 0; i < 23; ++i) a.in[i] = (const float*)d_in[i];
    a.out = (float*)d_out; a.ws = (unsigned char*)d_ws;
    hipLaunchKernelGGL(fwd, dim3(grid), dim3(NT), LDS_BYTES, stream, a);
}
```
